# Optimizing an MI355X kernel written in HIP

```python
import math
import jax, jax.numpy as jnp
from jax import lax
import numpy as np

D_MODEL = 1024
BATCH = 2
SEQ = 8192
DEPTH = 1
DEC_BATCH = 32
DEC_SEQ = 8
PAST_LEN = 8192
PAGE_SIZE = 128

ATTN_WIDTH = D_MODEL // 2
HEAD_DIM = 64
N_HEADS_A = ATTN_WIDTH // (2 * HEAD_DIM)
N_MAPS = 2 * N_HEADS_A
GMLP_WIDTH = D_MODEL - ATTN_WIDTH
N_GROUPS_B = 4
GROUP_B = GMLP_WIDTH // N_GROUPS_B
CHUNK = 128
IN_WIDTH = 3 * ATTN_WIDTH + 2 * GMLP_WIDTH
D_FF = 2816
N_BUCKETS = 32
MAX_DISTANCE = 128
Q_BLOCK = 128
EPS = 1e-6
NEG = -1e30

kernel_name = "hybrid_diffattn_gmlp_macaron_step"


def rmsnorm(x, g):
    xf = x.astype(jnp.float32)
    y = xf * lax.rsqrt(jnp.mean(xf * xf, axis=-1, keepdims=True) + EPS)
    return (y * g.astype(jnp.float32)).astype(x.dtype)


def swiglu(h, w_gu, w_down):
    gate, up = jnp.split(h @ w_gu, 2, axis=-1)
    return (jax.nn.silu(gate) * up) @ w_down


def rel_bucket(d):
    n = jnp.maximum(d, 0)
    max_exact = N_BUCKETS // 2
    nf = jnp.maximum(n, 1).astype(jnp.float32)
    large = max_exact + (jnp.log(nf / max_exact) / math.log(MAX_DISTANCE / max_exact)
                         * (N_BUCKETS - max_exact)).astype(jnp.int32)
    large = jnp.minimum(large, N_BUCKETS - 1)
    return jnp.where(n < max_exact, n, large)


def diff_attend(q, k, v, q_pos, k_pos, rel_table, lam):
    d = q_pos[:, None] - k_pos[None, :]
    bias = jnp.moveaxis(rel_table.astype(jnp.float32)[rel_bucket(d)], -1, 0)
    logits = jnp.einsum('bqmd,bkmd->bmqk', q.astype(jnp.float32), k.astype(jnp.float32))
    logits = logits * (HEAD_DIM ** -0.5) + bias
    logits = jnp.where(d >= 0, logits, NEG)
    p = jax.nn.softmax(logits, axis=-1)
    b, _, tq, tk = p.shape
    p = p.reshape(b, N_HEADS_A, 2, tq, tk)
    a = p[:, :, 0] - lam * p[:, :, 1]
    return jnp.einsum('bhqk,bkhe->bqhe', a.astype(v.dtype), v)


def chunk_spatial(v, w_s, b_s):
    b, t, _ = v.shape
    n_chunks = -(-t // CHUNK)
    pad = n_chunks * CHUNK - t
    vp = jnp.pad(v, ((0, 0), (0, pad), (0, 0))).reshape(b, n_chunks, CHUNK, N_GROUPS_B, GROUP_B)
    w = w_s * jnp.tril(jnp.ones((CHUNK, CHUNK), w_s.dtype))
    s = jnp.einsum('gij,bcjgd->bcigd', w, vp) + b_s.T[None, None, :, :, None]
    return s.reshape(b, n_chunks * CHUNK, GMLP_WIDTH)[:, :t]


def layer_forward(x, attend, lam, lam_init, nf1, wf1gu, wf1d, nm, w_in, subln, gnorm,
                  w_s, b_s, w_out, nf2, wf2gu, wf2d):
    b, t, _ = x.shape
    x = x + 0.5 * swiglu(rmsnorm(x, nf1), wf1gu, wf1d)
    h = rmsnorm(x, nm)
    q, k, v, u_pre, g_pre = jnp.split(
        h @ w_in, [ATTN_WIDTH, 2 * ATTN_WIDTH, 3 * ATTN_WIDTH, 3 * ATTN_WIDTH + GMLP_WIDTH], axis=-1)
    q = q.reshape(b, t, N_MAPS, HEAD_DIM)
    k = k.reshape(b, t, N_MAPS, HEAD_DIM)
    v = v.reshape(b, t, N_HEADS_A, 2 * HEAD_DIM)
    o = attend(q, k, v, lam)
    o = (rmsnorm(o, subln) * (1.0 - lam_init)).reshape(b, t, ATTN_WIDTH)
    u = jax.nn.gelu(u_pre)
    gv = rmsnorm(jax.nn.gelu(g_pre).reshape(b, t, N_GROUPS_B, GROUP_B),
                 gnorm.reshape(N_GROUPS_B, GROUP_B)).reshape(b, t, GMLP_WIDTH)
    s = u * chunk_spatial(gv, w_s, b_s)
    x = x + jnp.concatenate([o, s], axis=-1) @ w_out
    x = x + 0.5 * swiglu(rmsnorm(x, nf2), wf2gu, wf2d)
    return x, k, v, gv


def setup_inputs(seed: int = 0) -> dict:
    key = jax.random.key(seed)
    ks = jax.random.split(key, 26)
    f32 = jnp.float32
    n_pages = PAST_LEN // PAGE_SIZE
    n_used = DEC_BATCH * n_pages
    n_pool = (n_used * 5) // 4
    nrm = lambda k, shape, s: jax.random.normal(k, shape, f32) * s
    gain = lambda k, shape: 1.0 + 0.02 * jax.random.normal(k, shape, f32)
    page_table = jax.random.permutation(ks[0], n_pool)[:n_used].reshape(DEC_BATCH, n_pages).astype(jnp.int32)
    return {
        "x_prompt": nrm(ks[1], (BATCH, SEQ, D_MODEL), 1.0),
        "x_sample": nrm(ks[2], (DEC_BATCH, DEC_SEQ, D_MODEL), 1.0),
        "cache_k": nrm(ks[3], (DEPTH, n_pool, PAGE_SIZE, N_MAPS, HEAD_DIM), 1.0),
        "cache_v": nrm(ks[4], (DEPTH, n_pool, PAGE_SIZE, N_HEADS_A, 2 * HEAD_DIM), 1.0),
        "page_table": page_table,
        "rel_table": nrm(ks[5], (N_BUCKETS, N_MAPS), 0.5),
        "norm_ffn1": gain(ks[6], (DEPTH, D_MODEL)),
        "w_ffn1_gu": nrm(ks[7], (DEPTH, D_MODEL, 2 * D_FF), D_MODEL ** -0.5),
        "w_ffn1_down": nrm(ks[8], (DEPTH, D_FF, D_MODEL), D_FF ** -0.5),
        "norm_mix": gain(ks[9], (DEPTH, D_MODEL)),
        "w_in": nrm(ks[10], (DEPTH, D_MODEL, IN_WIDTH), D_MODEL ** -0.5),
        "lambda_q1": nrm(ks[11], (DEPTH, HEAD_DIM), 0.1),
        "lambda_k1": nrm(ks[12], (DEPTH, HEAD_DIM), 0.1),
        "lambda_q2": nrm(ks[13], (DEPTH, HEAD_DIM), 0.1),
        "lambda_k2": nrm(ks[14], (DEPTH, HEAD_DIM), 0.1),
        "subln": gain(ks[15], (DEPTH, 2 * HEAD_DIM)),
        "gmlp_norm": gain(ks[16], (DEPTH, GMLP_WIDTH)),
        "w_spatial": nrm(ks[17], (DEPTH, N_GROUPS_B, CHUNK, CHUNK), CHUNK ** -0.5),
        "b_spatial": gain(ks[18], (DEPTH, N_GROUPS_B, CHUNK)),
        "w_out": nrm(ks[19], (DEPTH, D_MODEL, D_MODEL), D_MODEL ** -0.5),
        "norm_ffn2": gain(ks[20], (DEPTH, D_MODEL)),
        "w_ffn2_gu": nrm(ks[21], (DEPTH, D_MODEL, 2 * D_FF), D_MODEL ** -0.5),
        "w_ffn2_down": nrm(ks[22], (DEPTH, D_FF, D_MODEL), D_FF ** -0.5),
        "norm_final": gain(ks[23], (D_MODEL,)),
    }


def reference(x_prompt, x_sample, cache_k, cache_v, page_table, rel_table, norm_ffn1, w_ffn1_gu,
              w_ffn1_down, norm_mix, w_in, lambda_q1, lambda_k1, lambda_q2, lambda_k2, subln,
              gmlp_norm, w_spatial, b_spatial, w_out, norm_ffn2, w_ffn2_gu, w_ffn2_down, norm_final):
    bs = x_sample.shape[0]
    t_p = x_prompt.shape[1]
    t_s = x_sample.shape[1]
    n_pages = page_table.shape[1]
    past_len = n_pages * cache_k.shape[2]
    pos_p = jnp.arange(t_p, dtype=jnp.int32)
    pos_s = past_len + jnp.arange(t_s, dtype=jnp.int32)
    kpos_s = jnp.arange(past_len + t_s, dtype=jnp.int32)

    def attend_prompt(q, k, v, lam):
        b = q.shape[0]
        nb = t_p // Q_BLOCK
        qb = jnp.moveaxis(q.reshape(b, nb, Q_BLOCK, N_MAPS, HEAD_DIM), 1, 0)
        pb = pos_p.reshape(nb, Q_BLOCK)
        ob = lax.map(lambda a: diff_attend(a[0], k, v, a[1], pos_p, rel_table, lam), (qb, pb))
        return jnp.moveaxis(ob, 0, 1).reshape(b, t_p, N_HEADS_A, 2 * HEAD_DIM)

    xp, xs = x_prompt, x_sample
    kp_l, vp_l, ks_l, vs_l, gs_l = [], [], [], [], []
    for l in range(DEPTH):
        lam_init = 0.8 - 0.6 * math.exp(-0.3 * l)
        lam = (jnp.exp(jnp.sum(lambda_q1[l].astype(jnp.float32) * lambda_k1[l].astype(jnp.float32)))
               - jnp.exp(jnp.sum(lambda_q2[l].astype(jnp.float32) * lambda_k2[l].astype(jnp.float32)))
               + lam_init)
        ck, cv = cache_k[l], cache_v[l]

        def attend_sample(q, k, v, lam, ck=ck, cv=cv):
            k_past = ck[page_table].reshape(bs, past_len, N_MAPS, HEAD_DIM).astype(k.dtype)
            v_past = cv[page_table].reshape(bs, past_len, N_HEADS_A, 2 * HEAD_DIM).astype(v.dtype)
            k_all = jnp.concatenate([k_past, k], axis=1)
            v_all = jnp.concatenate([v_past, v], axis=1)
            return diff_attend(q, k_all, v_all, pos_s, kpos_s, rel_table, lam)

        w = (norm_ffn1[l], w_ffn1_gu[l], w_ffn1_down[l], norm_mix[l], w_in[l], subln[l],
             gmlp_norm[l], w_spatial[l], b_spatial[l], w_out[l], norm_ffn2[l], w_ffn2_gu[l],
             w_ffn2_down[l])
        xp, kp, vp, _ = layer_forward(xp, attend_prompt, lam, lam_init, *w)
        xs, kn, vn, gn = layer_forward(xs, attend_sample, lam, lam_init, *w)
        kp_l.append(kp)
        vp_l.append(vp)
        ks_l.append(kn)
        vs_l.append(vn)
        gs_l.append(gn)

    y_prompt = rmsnorm(xp, norm_final)
    y_sample = rmsnorm(xs, norm_final)
    k_prompt = jnp.stack(kp_l)
    v_prompt = jnp.stack(vp_l)
    k_sample = jnp.stack(ks_l)
    v_sample = jnp.stack(vs_l)
    gmlp_v_sample = jnp.stack(gs_l)
    return (y_prompt, y_sample, k_prompt, v_prompt, k_sample, v_sample, gmlp_v_sample)
```

```cpp
#include <hip/hip_runtime.h>
#include <cstdio>
#include <cstdint>

#define LAS __attribute__((address_space(3)))
#define GAS __attribute__((address_space(1)))
typedef unsigned short bf16_t;
typedef short bf16x8 __attribute__((ext_vector_type(8)));
typedef short s16x4 __attribute__((ext_vector_type(4)));
typedef float f32x2 __attribute__((ext_vector_type(2)));
typedef float f32x4 __attribute__((ext_vector_type(4)));
typedef float f32x16 __attribute__((ext_vector_type(16)));
typedef unsigned u32x2 __attribute__((ext_vector_type(2)));
typedef unsigned u32x4 __attribute__((ext_vector_type(4)));

constexpr int DM = 1024, SEQ = 8192, MP = 16384, MS = 256, MT = 16640, DFF = 2816, NGU = 5632, NIN = 2560, AW = 512;
constexpr int NPAGES = 64, PAGE = 128;
constexpr float EPS = 1e-6f, LOG2E = 1.4426950408889634f, C2 = 0.125f * 1.4426950408889634f;
constexpr float LAM_INIT = 0.2f;
constexpr int NWAVES = 8;
#ifndef MK_N_LAUNCHES
#define MK_N_LAUNCHES 1
#endif
constexpr int N_LAUNCHES = MK_N_LAUNCHES;
constexpr int PER_PHASE = 10;

constexpr size_t O_Y = 0, O_KP = (size_t)MT * DM, O_VP = O_KP + (size_t)MP * AW, O_KS = O_VP + (size_t)MP * AW, O_VS = O_KS + (size_t)MS * AW, O_GS = O_VS + (size_t)MS * AW, O_END = O_GS + (size_t)MS * AW;

constexpr size_t MiB = 1u << 20;
constexpr size_t WS_CTL = 0, CTL_ZERO_BYTES = 1 * MiB;
constexpr size_t WS_WGU1 = 2 * MiB, WS_WD1 = 13 * MiB, WS_WIN = 19 * MiB, WS_WOUT = 24 * MiB, WS_WGU2 = 26 * MiB, WS_WD2 = 37 * MiB;
constexpr size_t WS_WTRIL = 43 * MiB, WS_BTAB = 43 * MiB + 256 * 1024, WS_SSQ = 44 * MiB, WS_SPART = 46 * MiB;
constexpr size_t WS_XB = 64 * MiB, WS_Q = 100 * MiB, WS_K = 120 * MiB, WS_V = 140 * MiB, WS_U = 160 * MiB, WS_GV = 180 * MiB, WS_MIX = 200 * MiB;
constexpr size_t WS_X1 = 240 * MiB, WS_H = 320 * MiB, WS_END = 416 * MiB;
constexpr int CW_TMO = 0, CW_BAR = 4096;
constexpr int SPART_F = 16 + 16 + 16 * 128;

constexpr int RING_BYTES = 131072;
constexpr int LDSCTL_OFF = RING_BYTES, MISC_OFF = LDSCTL_OFF + 320;
constexpr int RSTAB_OFF = RING_BYTES + 512;
constexpr int GX_OFF = RSTAB_OFF + 6144;
constexpr int LDS_BYTES = 147456;
static_assert(GX_OFF + 8192 <= LDS_BYTES, "LDS map");

__device__ __forceinline__ unsigned cvt_pk_bf16(float lo, float hi) { unsigned r; asm("v_cvt_pk_bf16_f32 %0, %1, %2" : "=v"(r) : "v"(lo), "v"(hi)); return r; }
__device__ __forceinline__ float bf2f(bf16_t v) { return __uint_as_float((unsigned)v << 16); }
__device__ __forceinline__ float silu_f(float x) { return x * __builtin_amdgcn_rcpf(1.f + __builtin_amdgcn_exp2f(-x * LOG2E)); }
__device__ __forceinline__ float gelu_f(float x) { const float z2 = x * (1.5957691216f + 0.0713548163f * x * x); return x * __builtin_amdgcn_rcpf(1.f + __builtin_amdgcn_exp2f(-z2 * LOG2E)); }
__device__ __forceinline__ float wave_sum(float v) {
#pragma unroll
    for (int o = 1; o < 64; o <<= 1) v += __shfl_xor(v, o);
    return v;
}
#define LDS_WAIT() asm volatile("s_waitcnt lgkmcnt(0)" ::: "memory")
#define VM_WAIT() asm volatile("s_waitcnt vmcnt(0)" ::: "memory")

namespace pg8 {
constexpr int BM = 256, BK = 64, HALF = 128, HTB = HALF * BK * 2, STAGE_BYTES = 8 * HTB, NXCD = 8, WGM = 8;
__host__ __device__ __forceinline__ int lds_byte(int r, int c) { const int st = (r >> 4) * 2 + (c >> 5), rr = r & 15, cc = c & 31, ob = rr * 64 + cc * 2; return st * 1024 + (ob ^ (((ob >> 9) & 1) << 5)); }
__host__ __device__ __forceinline__ void stage_rc(int b, int& R, int& C) { const int st = b / 1024, sb = b % 1024, swz = sb ^ (((sb >> 9) & 1) << 5); R = (st >> 1) * 16 + swz / 64; C = (st & 1) * 32 + (swz % 64) / 2; }
__host__ __device__ __forceinline__ int perm32(int rho) { const int n = rho >> 4, i = rho & 15; return 8 * (i >> 2) + 4 * n + (i & 3); }

struct Unit { int pm, pn, idx; };
struct Gemm { const bf16_t* A; const bf16_t* Bt; int M, N, K; };

struct StaticOrder {
    int nM, nN, nwg, G, c;
    __host__ __device__ void init(int M, int N, int G_, int c_) { nM = M / BM; nN = N / BM; nwg = nM * nN; G = G_; c = c_; }
    __host__ __device__ bool next(int i, Unit& u) const {
        const long L = (long)i * G + c; if (L >= nwg) return false;
        int wgid = (int)L; { const int q = nwg / NXCD, r = nwg % NXCD, xcd = wgid % NXCD, off = wgid / NXCD; wgid = (xcd < r ? xcd * (q + 1) : r * (q + 1) + (xcd - r) * q) + off; }
        const int nig = WGM * nN, gid = wgid / nig, fm = gid * WGM, gsz = (nM - fm) < WGM ? (nM - fm) : WGM;
        u.pm = fm + ((wgid % nig) % gsz); u.pn = (wgid % nig) / gsz; u.idx = i; return true;
    }
    __device__ __forceinline__ void a_ready(const Unit&) const {}
    __device__ __forceinline__ void done(const Unit&) const {}
};

struct EpiSwiGLU {
    static constexpr bool PERM = true, AFTER_DRAIN = false;
    bf16_t* H; const LAS float* rstab;
    __device__ __forceinline__ void operator()(const f32x4 (&acc)[2][2][4][2], const Unit& u, int wr, int wc, int fr, int fq) const {
        const int col0 = u.pn * 128 + wc * 32 + 8 * fq;
#pragma unroll
        for (int ai = 0; ai < 2; ++ai)
#pragma unroll
            for (int m = 0; m < 4; ++m) {
                const int rin = ai * HALF + wr * 64 + m * 16 + fr; const float rs = rstab[u.idx * 256 + rin];
                float h[8];
#pragma unroll
                for (int n = 0; n < 2; ++n)
#pragma unroll
                    for (int j = 0; j < 4; ++j) h[n * 4 + j] = silu_f(acc[ai][0][m][n][j] * rs) * (acc[ai][1][m][n][j] * rs);
                u32x4 w; w.x = cvt_pk_bf16(h[0], h[1]); w.y = cvt_pk_bf16(h[2], h[3]); w.z = cvt_pk_bf16(h[4], h[5]); w.w = cvt_pk_bf16(h[6], h[7]);
                *(u32x4*)(H + (size_t)(u.pm * BM + rin) * DFF + col0) = w;
            }
    }
};
struct EpiResid {
    static constexpr bool PERM = true, AFTER_DRAIN = false;
    const float* xold; float* xnew; bf16_t* xb; float* ssq; float alpha;
    __device__ __forceinline__ void operator()(const f32x4 (&acc)[2][2][4][2], const Unit& u, int wr, int wc, int fr, int fq) const {
        const int col0 = u.pn * BM + wc * 32 + 8 * fq;
#pragma unroll
        for (int ai = 0; ai < 2; ++ai)
#pragma unroll
            for (int m = 0; m < 4; ++m) {
                const int row = u.pm * BM + ai * HALF + wr * 64 + m * 16 + fr; const size_t off = (size_t)row * DM + col0; float ss = 0.f;
#pragma unroll
                for (int bj = 0; bj < 2; ++bj) {
                    const f32x4 o0 = *(const f32x4*)(xold + off + bj * HALF), o1 = *(const f32x4*)(xold + off + bj * HALF + 4);
                    const f32x4 n0 = o0 + acc[ai][bj][m][0] * alpha, n1 = o1 + acc[ai][bj][m][1] * alpha;
                    *(f32x4*)(xnew + off + bj * HALF) = n0; *(f32x4*)(xnew + off + bj * HALF + 4) = n1;
                    ss += (n0[0] * n0[0] + n0[1] * n0[1]) + (n0[2] * n0[2] + n0[3] * n0[3]) + (n1[0] * n1[0] + n1[1] * n1[1]) + (n1[2] * n1[2] + n1[3] * n1[3]);
                    u32x4 w; w.x = cvt_pk_bf16(n0[0], n0[1]); w.y = cvt_pk_bf16(n0[2], n0[3]); w.z = cvt_pk_bf16(n1[0], n1[1]); w.w = cvt_pk_bf16(n1[2], n1[3]);
                    *(u32x4*)(xb + off + bj * HALF) = w;
                }
                ss += __shfl_xor(ss, 16); ss += __shfl_xor(ss, 32);
                if (fq == 0) ssq[(size_t)row * 16 + u.pn * 4 + wc] = ss;
                asm volatile("" ::: "memory");
            }
    }
};
struct EpiWin {
    static constexpr bool PERM = true, AFTER_DRAIN = false;
    bf16_t *Qb, *Kb, *Vb, *Ub, *GVb; float* out; const float* gnorm; const LAS float* rstab; LAS float* gx;
    __device__ __forceinline__ void operator()(const f32x4 (&acc)[2][2][4][2], const Unit& u, int wr, int wc, int fr, int fq) const {
        const int kind = u.pn >> 1;
        const int cbase = (u.pn & 1) * 256 + wc * 32 + 8 * fq;
        if (kind == 4) {
#pragma unroll
            for (int ai = 0; ai < 2; ++ai)
#pragma unroll
                for (int m = 0; m < 4; ++m) {
                    const int rin = ai * HALF + wr * 64 + m * 16 + fr; const float rs = rstab[u.idx * 256 + rin];
#pragma unroll
                    for (int bj = 0; bj < 2; ++bj) {
                        float ss = 0.f;
#pragma unroll
                        for (int n = 0; n < 2; ++n)
#pragma unroll
                            for (int j = 0; j < 4; ++j) { const float g = gelu_f(acc[ai][bj][m][n][j] * rs); ss += g * g; }
                        ss += __shfl_xor(ss, 16); ss += __shfl_xor(ss, 32);
                        if (fq == 0) gx[(rin * 2 + bj) * 4 + wc] = ss;
                    }
                }
            asm volatile("s_waitcnt lgkmcnt(0)\n\ts_barrier" ::: "memory");
        }
#pragma unroll
        for (int ai = 0; ai < 2; ++ai)
#pragma unroll
            for (int m = 0; m < 4; ++m) {
                const int rin = ai * HALF + wr * 64 + m * 16 + fr; const int row = u.pm * BM + rin; const float rs = rstab[u.idx * 256 + rin];
#pragma unroll
                for (int bj = 0; bj < 2; ++bj) {
                    const int col = cbase + bj * HALF;
                    f32x4 v0 = acc[ai][bj][m][0] * rs, v1 = acc[ai][bj][m][1] * rs;
                    bf16_t* dst;
                    if (kind == 0) { v0 = v0 * C2; v1 = v1 * C2; dst = Qb; }
                    else if (kind == 1 || kind == 2) {
                        dst = (kind == 1) ? Kb : Vb;
                        float* o = out + ((row < MP) ? ((kind == 1 ? O_KP : O_VP) + (size_t)row * AW) : ((kind == 1 ? O_KS : O_VS) + (size_t)(row - MP) * AW)) + col;
                        *(f32x4*)o = v0; *(f32x4*)(o + 4) = v1;
                    } else if (kind == 3) {
#pragma unroll
                        for (int j = 0; j < 4; ++j) { v0[j] = gelu_f(v0[j]); v1[j] = gelu_f(v1[j]); }
                        dst = Ub;
                    } else {
                        const LAS f32x4* gp = (const LAS f32x4*)(gx + (rin * 2 + bj) * 4); const f32x4 p = *gp;
                        const float rg = __builtin_amdgcn_rsqf(((p[0] + p[1]) + (p[2] + p[3])) * (1.f / 128.f) + EPS);
                        const f32x4 g0 = *(const f32x4*)(gnorm + col), g1 = *(const f32x4*)(gnorm + col + 4);
#pragma unroll
                        for (int j = 0; j < 4; ++j) { v0[j] = gelu_f(v0[j]) * rg * g0[j]; v1[j] = gelu_f(v1[j]) * rg * g1[j]; }
                        dst = GVb;
                        if (row >= MP) { float* o = out + O_GS + (size_t)(row - MP) * AW + col; *(f32x4*)o = v0; *(f32x4*)(o + 4) = v1; }
                    }
                    u32x4 w; w.x = cvt_pk_bf16(v0[0], v0[1]); w.y = cvt_pk_bf16(v0[2], v0[3]); w.z = cvt_pk_bf16(v1[0], v1[1]); w.w = cvt_pk_bf16(v1[2], v1[3]);
                    *(u32x4*)(dst + (size_t)row * AW + col) = w;
                }
                asm volatile("" ::: "memory");
            }
    }
};

template <class Epi, class Sched, bool ALIGN_EPI = false, bool SP2 = true>
__device__ __forceinline__ void gemm_phase(LAS unsigned char* lds, const Gemm g, const Sched& S, const Epi& E) {
    const int tid = threadIdx.x, wid = __builtin_amdgcn_readfirstlane(tid >> 6), lane = tid & 63, wr = wid >> 2, wc = wid & 3, fr = lane & 15, fq = lane >> 4;
    const int K = g.K, nt = K / BK;
    unsigned voffA[2], voffB[2];
#pragma unroll
    for (int i = 0; i < 2; ++i) { int R, C; stage_rc(tid * 16 + i * 8192, R, C); const int Rb = Epi::PERM ? ((R & ~31) + perm32(R & 31)) : R;
        voffA[i] = (unsigned)(R * K + C) * 2u; voffB[i] = (unsigned)(Rb * K + C) * 2u; }
    const size_t kstep = (size_t)(BK * 2);
    const size_t hstep = (size_t)HALF * K * 2;
    const size_t tstep = 2 * hstep;
    const unsigned ldsw = (unsigned)wid * 1024u;
    const int aoff = lds_byte(wr * 64 + fr, fq * 8), boff = lds_byte(wc * 32 + fr, fq * 8);
#define PG8_SA(b, h) (((b) * 2 + (h)) * HTB)
#define PG8_SB(b, h) ((4 + (b) * 2 + (h)) * HTB)
#define PG8_STAGE(bufoff, gbase, voff) do { _Pragma("unroll") for (int _i = 0; _i < 2; ++_i) \
        __builtin_amdgcn_global_load_lds((const unsigned*)((const char*)(gbase) + (voff)[_i]), (LAS unsigned*)(lds + (bufoff) + ldsw + _i * 8192), 16, 0, 0); } while (0)
#define PG8_LDA(dst, b, h) do { _Pragma("unroll") for (int m = 0; m < 4; ++m) _Pragma("unroll") for (int k = 0; k < 2; ++k) dst[m][k] = *(const LAS bf16x8*)(lds + PG8_SA(b, h) + aoff + m * 2048 + k * 1024); } while (0)
#define PG8_LDB(dst, b, h) do { _Pragma("unroll") for (int n = 0; n < 2; ++n) _Pragma("unroll") for (int k = 0; k < 2; ++k) dst[n][k] = *(const LAS bf16x8*)(lds + PG8_SB(b, h) + boff + n * 2048 + k * 1024); } while (0)
#define PG8_MMA(ai, bj, At, Bt) do { __builtin_amdgcn_s_setprio(1); _Pragma("unroll") for (int m = 0; m < 4; ++m) _Pragma("unroll") for (int n = 0; n < 2; ++n) _Pragma("unroll") for (int k = 0; k < 2; ++k) \
        acc[ai][bj][m][n] = __builtin_amdgcn_mfma_f32_16x16x32_bf16(Bt[n][k], At[m][k], acc[ai][bj][m][n], 0, 0, 0); __builtin_amdgcn_s_setprio(0); } while (0)
#define PG8_WAIT_V(n) asm volatile("s_waitcnt vmcnt(" #n ")" ::: "memory")
#define PG8_WAIT_L(n) asm volatile("s_waitcnt lgkmcnt(" #n ")" ::: "memory")
#define PG8_BAR __builtin_amdgcn_s_barrier()
#define PG8_SCHED __builtin_amdgcn_sched_barrier(0)
    Unit cur, nxt; int ui = 0;
    if (!S.next(0, cur)) return;
    f32x4 acc[2][2][4][2];
#pragma unroll
    for (int a = 0; a < 2; ++a)
#pragma unroll
        for (int b = 0; b < 2; ++b)
#pragma unroll
            for (int m = 0; m < 4; ++m)
#pragma unroll
                for (int n = 0; n < 2; ++n) acc[a][b][m][n] = (f32x4){0.f, 0.f, 0.f, 0.f};
    bf16x8 At[4][2], B0[2][2], B1[2][2];
    const char* cA = (const char*)g.A + (size_t)cur.pm * tstep; const char* cB = (const char*)g.Bt + (size_t)cur.pn * tstep;
    S.a_ready(cur);
    PG8_STAGE(PG8_SB(0, 0), cB, voffB); PG8_STAGE(PG8_SB(0, 1), cB + hstep, voffB); PG8_STAGE(PG8_SA(0, 0), cA, voffA); PG8_STAGE(PG8_SA(0, 1), cA + hstep, voffA);
    if (wr == 1) PG8_BAR;
    PG8_WAIT_V(2); PG8_BAR;
    PG8_STAGE(PG8_SB(1, 0), cB + kstep, voffB); PG8_STAGE(PG8_SA(1, 0), cA + kstep, voffA); PG8_STAGE(PG8_SB(1, 1), cB + hstep + kstep, voffB);
    PG8_WAIT_V(6); PG8_BAR;
    for (;;) {
        const bool has_next = S.next(ui + 1, nxt);
        const char* nA = has_next ? (const char*)g.A + (size_t)nxt.pm * tstep : cA; const char* nB = has_next ? (const char*)g.Bt + (size_t)nxt.pn * tstep : cB;
        for (int t = 0; t < nt; t += 2) {
            const bool last = (t == nt - 2);
            const char* a1 = cA + (size_t)(t + 1) * kstep;
            const char* a2 = last ? nA : cA + (size_t)(t + 2) * kstep; const char* b2 = last ? nB : cB + (size_t)(t + 2) * kstep;
            const char* a3 = a2 + kstep; const char* b3 = b2 + kstep;
            if (last && has_next) S.a_ready(nxt);
            PG8_LDB(B0, 0, 0); PG8_LDB(B1, 0, 1); PG8_SCHED; PG8_LDA(At, 0, 0); PG8_STAGE(PG8_SA(1, 1), a1 + hstep, voffA);
            PG8_WAIT_V(8); PG8_WAIT_L(0); PG8_BAR; PG8_MMA(0, 0, At, B0); PG8_MMA(0, 1, At, B1); PG8_BAR; PG8_SCHED;
            PG8_LDA(At, 0, 1); PG8_STAGE(PG8_SB(0, 0), b2, voffB); PG8_STAGE(PG8_SB(0, 1), b2 + hstep, voffB); PG8_STAGE(PG8_SA(0, 0), a2, voffA);
            PG8_WAIT_V(8); PG8_WAIT_L(0); PG8_BAR; PG8_MMA(1, 0, At, B0); PG8_MMA(1, 1, At, B1); PG8_BAR; PG8_SCHED;
            PG8_LDB(B0, 1, 0); PG8_LDB(B1, 1, 1); PG8_SCHED; PG8_LDA(At, 1, 0); PG8_STAGE(PG8_SA(0, 1), a2 + hstep, voffA);
            PG8_WAIT_V(8); PG8_WAIT_L(0); PG8_BAR; PG8_MMA(0, 0, At, B0); PG8_MMA(0, 1, At, B1); PG8_BAR; PG8_SCHED;
            PG8_LDA(At, 1, 1); PG8_STAGE(PG8_SB(1, 0), b3, voffB); PG8_STAGE(PG8_SB(1, 1), b3 + hstep, voffB); PG8_STAGE(PG8_SA(1, 0), a3, voffA);
            PG8_WAIT_V(8); PG8_WAIT_L(0); PG8_BAR; PG8_MMA(1, 0, At, B0); PG8_MMA(1, 1, At, B1); PG8_BAR; PG8_SCHED;
        }
        if constexpr (ALIGN_EPI) { if (wr == 0) PG8_BAR; }
        E(acc, cur, wr, wc, fr, fq); S.done(cur);
        if (!has_next) break;
#pragma unroll
        for (int a = 0; a < 2; ++a)
#pragma unroll
            for (int b = 0; b < 2; ++b)
#pragma unroll
                for (int m = 0; m < 4; ++m)
#pragma unroll
                    for (int n = 0; n < 2; ++n) acc[a][b][m][n] = (f32x4){0.f, 0.f, 0.f, 0.f};
        cur = nxt; cA = nA; cB = nB; ++ui;
        if constexpr (ALIGN_EPI) { if (wr == 1) PG8_BAR; }
    }
    PG8_WAIT_V(0);
    if constexpr (!ALIGN_EPI) { if (wr == 0) PG8_BAR; }
    PG8_BAR;
#undef PG8_SA
#undef PG8_SB
#undef PG8_STAGE
#undef PG8_LDA
#undef PG8_LDB
#undef PG8_MMA
#undef PG8_WAIT_V
#undef PG8_WAIT_L
#undef PG8_BAR
#undef PG8_SCHED
}
}

#define XB_TMO      128
#define XB_XCNT(j)  (256  + 64 * (j))
#define XB_XSUB(j)  (1280 + 64 * (j))
#define XB_XGEN(j)  (2304 + 64 * (j))
#define XB_TOP      3328
#define XB_TOPGEN   3392
#define XCD_BAR_WORDS 3456
#define XB_SPIN_CAP (1u << 18)
__device__ __forceinline__ unsigned xb_ld(unsigned* p)              { return __hip_atomic_load(p, __ATOMIC_RELAXED, __HIP_MEMORY_SCOPE_AGENT); }
__device__ __forceinline__ unsigned xb_add(unsigned* p, unsigned v) { return __hip_atomic_fetch_add(p, v, __ATOMIC_RELAXED, __HIP_MEMORY_SCOPE_AGENT); }
__device__ __forceinline__ unsigned xb_xcc_id() { return (unsigned)__builtin_amdgcn_s_getreg((3 << 11) | 20) & 0xFu; }
#define XB_SPIN(cond, bar) do { unsigned _sp = 0; while (cond) { __builtin_amdgcn_s_sleep(1); \
    if ((++_sp & 255u) == 0u) { if (xb_ld(&(bar)[XB_TMO])) break; if (_sp > XB_SPIN_CAP) { atomicAdd(&(bar)[XB_TMO], 1u); break; } } } } while (0)
struct XcdBarrier { unsigned* bar; unsigned x; volatile LAS unsigned* st; };
__device__ __forceinline__ XcdBarrier xcd_barrier_post(unsigned* bar, volatile LAS unsigned* st) {
    XcdBarrier b; b.bar = bar; b.x = xb_xcc_id(); b.st = st;
    if (threadIdx.x == 0) (void)xb_add(&bar[XB_XCNT(b.x)], 1u);
    return b;
}
__device__ __forceinline__ void xcd_barrier_complete(unsigned* bar, unsigned x, unsigned& nloc, unsigned& nx) {
    const unsigned G = gridDim.x * gridDim.y * gridDim.z;
    unsigned sum, cnt, mine, sp = 0u;
    for (;;) {
        sum = 0u; cnt = 0u; mine = 0u;
#pragma unroll
        for (unsigned j = 0; j < 16; ++j) { const unsigned c = xb_ld(&bar[XB_XCNT(j)]); sum += c; cnt += (c > 0u) ? 1u : 0u; mine = (j == x) ? c : mine; }
        if (sum == G) break;
        __builtin_amdgcn_s_sleep(1);
        if ((++sp & 255u) == 0u) { if (xb_ld(&bar[XB_TMO])) break; if (sp > XB_SPIN_CAP) { atomicAdd(&bar[XB_TMO], 1u); break; } }
    }
    nloc = mine > 0u ? mine : 1u; nx = cnt > 0u ? cnt : 1u;
}
__device__ __forceinline__ void xcd_barrier(const XcdBarrier& b) {
    asm volatile("s_waitcnt vmcnt(0)" ::: "memory");
    __syncthreads();
    if (threadIdx.x == 0) {
        unsigned* bar = b.bar;
        __builtin_amdgcn_s_waitcnt(0);
        unsigned nloc = b.st[0], nx = b.st[1];
        if (nloc == 0u) { xcd_barrier_complete(bar, b.x, nloc, nx); b.st[0] = nloc; b.st[1] = nx; }
        const unsigned old = xb_add(&bar[XB_XSUB(b.x)], 1u);
        const unsigned gen = old / nloc;
        if (old + 1u == (gen + 1u) * nloc) {
            __builtin_amdgcn_fence(__ATOMIC_RELEASE, "agent");
            asm volatile("s_waitcnt vmcnt(0)" ::: "memory");
            const unsigned og = xb_add(&bar[XB_TOP], 1u);
            const unsigned tg = og / nx;
            if (og + 1u == (tg + 1u) * nx) xb_add(&bar[XB_TOPGEN], 1u);
            else XB_SPIN(xb_ld(&bar[XB_TOPGEN]) == tg, bar);
            __builtin_amdgcn_fence(__ATOMIC_ACQUIRE, "agent");
            xb_add(&bar[XB_XGEN(b.x)], 1u);
            asm volatile("s_waitcnt vmcnt(0)" ::: "memory");
        } else {
            XB_SPIN(xb_ld(&bar[XB_XGEN(b.x)]) == gen, bar);
            __builtin_amdgcn_fence(__ATOMIC_ACQUIRE, "agent");
            asm volatile("s_waitcnt vmcnt(0)" ::: "memory");
        }
    }
    __syncthreads();
}

struct Args { const float* in[24]; const int* page_table; float* out; unsigned char* ws; int ph_lo, ph_hi, li, pad; };
enum { I_XP = 0, I_XS, I_CK, I_CV, I_PT, I_REL, I_NF1, I_WGU1, I_WD1, I_NM, I_WIN, I_LQ1, I_LK1, I_LQ2, I_LK2, I_SUBLN, I_GNORM, I_WS, I_BS, I_WOUT, I_NF2, I_WGU2, I_WD2, I_NFIN };

struct Frame {
    LAS unsigned char* lds; volatile LAS unsigned* MISC; unsigned* ctl;
    int tid, lane, wave, vcu, G;
    unsigned char* ws; float* out;
};

__device__ __forceinline__ void p0_transpose_item(const float* W, int K, int N, bf16_t* WT, int drow0, int k0, int n0, const float* gain, LAS float* scr, int lane) {
#pragma unroll 8
    for (int i = 0; i < 32; ++i) { const int kk = 2 * i + (lane >> 5); float v = W[(size_t)(k0 + kk) * N + n0 + (lane & 31)]; if (gain) v *= gain[k0 + kk]; scr[kk * 33 + (lane & 31)] = v; }
    LDS_WAIT(); asm volatile("" ::: "memory");
    const int c = lane & 7;
#pragma unroll
    for (int j = 0; j < 4; ++j) { const int n = (lane >> 3) + 8 * j; const LAS float* s = scr + (8 * c) * 33 + n;
        u32x4 o; o.x = cvt_pk_bf16(s[0 * 33], s[1 * 33]); o.y = cvt_pk_bf16(s[2 * 33], s[3 * 33]); o.z = cvt_pk_bf16(s[4 * 33], s[5 * 33]); o.w = cvt_pk_bf16(s[6 * 33], s[7 * 33]);
        *(u32x4*)(WT + (size_t)(drow0 + n) * K + k0 + 8 * c) = o; }
    LDS_WAIT(); asm volatile("" ::: "memory");
}
__device__ __forceinline__ int gu_drow(int n0) { return (n0 < DFF) ? ((n0 >> 7) * 256 + (n0 & 127)) : (((n0 - DFF) >> 7) * 256 + 128 + ((n0 - DFF) & 127)); }

__device__ __forceinline__ void p0_prologue(Frame& F, const Args& a) {
    LAS float* scr = (LAS float*)(F.lds + F.wave * 16384);
    const int gw = F.vcu * NWAVES + F.wave, NGW = F.G * NWAVES;
    constexpr int I_GU = (DM / 64) * (NGU / 32), I_DN = (DFF / 64) * (DM / 32), I_IN = (DM / 64) * (NIN / 32), I_OUT = (DM / 64) * (DM / 32);
    constexpr int NITEMS = 2 * I_GU + 2 * I_DN + I_IN + I_OUT;
    for (int it = gw; it < NITEMS; it += NGW) {
        int r = it;
        if (r < I_GU) { const int nb = NGU / 32, k0 = 64 * (r / nb), n0 = 32 * (r % nb); p0_transpose_item(a.in[I_WGU1], DM, NGU, (bf16_t*)(F.ws + WS_WGU1), gu_drow(n0), k0, n0, a.in[I_NF1], scr, F.lane); continue; } r -= I_GU;
        if (r < I_GU) { const int nb = NGU / 32, k0 = 64 * (r / nb), n0 = 32 * (r % nb); p0_transpose_item(a.in[I_WGU2], DM, NGU, (bf16_t*)(F.ws + WS_WGU2), gu_drow(n0), k0, n0, a.in[I_NF2], scr, F.lane); continue; } r -= I_GU;
        if (r < I_DN) { const int nb = DM / 32, k0 = 64 * (r / nb), n0 = 32 * (r % nb); p0_transpose_item(a.in[I_WD1], DFF, DM, (bf16_t*)(F.ws + WS_WD1), n0, k0, n0, nullptr, scr, F.lane); continue; } r -= I_DN;
        if (r < I_DN) { const int nb = DM / 32, k0 = 64 * (r / nb), n0 = 32 * (r % nb); p0_transpose_item(a.in[I_WD2], DFF, DM, (bf16_t*)(F.ws + WS_WD2), n0, k0, n0, nullptr, scr, F.lane); continue; } r -= I_DN;
        if (r < I_IN) { const int nb = NIN / 32, k0 = 64 * (r / nb), n0 = 32 * (r % nb); p0_transpose_item(a.in[I_WIN], DM, NIN, (bf16_t*)(F.ws + WS_WIN), n0, k0, n0, a.in[I_NM], scr, F.lane); continue; } r -= I_IN;
        { const int nb = DM / 32, k0 = 64 * (r / nb), n0 = 32 * (r % nb); p0_transpose_item(a.in[I_WOUT], DM, DM, (bf16_t*)(F.ws + WS_WOUT), n0, k0, n0, nullptr, scr, F.lane); }
    }
    bf16_t* XB = (bf16_t*)(F.ws + WS_XB); float* SSQ = (float*)(F.ws + WS_SSQ);
    for (int m = gw; m < MT; m += NGW) {
        const float* xrow = (m < MP) ? a.in[I_XP] + (size_t)m * DM : a.in[I_XS] + (size_t)(m - MP) * DM;
        const f32x4* xr = (const f32x4*)xrow + F.lane; f32x4 v[4]; float s = 0.f;
#pragma unroll
        for (int j = 0; j < 4; ++j) { v[j] = xr[64 * j]; s += (v[j].x * v[j].x + v[j].y * v[j].y) + (v[j].z * v[j].z + v[j].w * v[j].w); }
        s = wave_sum(s);
        u32x2* o8 = (u32x2*)(XB + (size_t)m * DM) + F.lane;
#pragma unroll
        for (int j = 0; j < 4; ++j) { u32x2 w; w.x = cvt_pk_bf16(v[j].x, v[j].y); w.y = cvt_pk_bf16(v[j].z, v[j].w); o8[64 * j] = w; }
        if (F.lane < 16) SSQ[(size_t)m * 16 + F.lane] = (F.lane == 0) ? s : 0.f;
    }
    const int gt = F.vcu * 512 + F.tid, NGT = F.G * 512;
    bf16_t* WT = (bf16_t*)(F.ws + WS_WTRIL);
    for (int e = gt; e < 4 * 128 * 128; e += NGT) { const int i = (e >> 7) & 127, j = e & 127; const float w = (j <= i) ? a.in[I_WS][e] : 0.f; WT[e] = (bf16_t)(cvt_pk_bf16(w, 0.f) & 0xffffu); }
    float* BT = (float*)(F.ws + WS_BTAB);
    for (int e = gt; e < 8 * 128; e += NGT) { const int m = e >> 7, d = e & 127; int bk;
        if (d < 16) bk = d; else { bk = 16 + (int)(__logf((float)d * (1.f / 16.f)) / 2.0794415416798357f * 16.f); if (bk > 31) bk = 31; }
        BT[e] = a.in[I_REL][bk * 8 + m] * LOG2E; }
}

template <class Sched> __device__ __forceinline__ void rstab_fill(Frame& F, const Sched& S) {
    LAS float* rstab = (LAS float*)(F.lds + RSTAB_OFF); const float* SSQ = (const float*)(F.ws + WS_SSQ);
    pg8::Unit u;
    for (int i = 0; i < 6 && S.next(i, u); ++i) {
        if ((i & 1) == (F.tid >> 8)) { const int r = F.tid & 255; const f32x4* p = (const f32x4*)(SSQ + (size_t)(u.pm * 256 + r) * 16);
            const f32x4 a = p[0], b = p[1], c = p[2], d = p[3]; const f32x4 s = (a + b) + (c + d);
            rstab[i * 256 + r] = __builtin_amdgcn_rsqf(((s[0] + s[1]) + (s[2] + s[3])) * (1.f / DM) + EPS); }
    }
    __syncthreads();
}

__device__ __forceinline__ void mini_gemm_resid(Frame& F, const bf16_t* A, const bf16_t* Bt, int K, const float* xold, int xoff, float* xnew, bf16_t* xb, float alpha) {
    LAS float* red = (LAS float*)F.lds;
    LAS float* ssr = (LAS float*)(F.lds + 32768);
    float* SSQ = (float*)(F.ws + WS_SSQ);
    const int fr = F.lane & 15, fq = F.lane >> 4, kw = K / 8;
    for (int t = F.vcu; t < 256; t += F.G) {
        const int rb = t >> 4, cb = t & 15;
        f32x4 acc[4];
#pragma unroll
        for (int n = 0; n < 4; ++n) acc[n] = (f32x4){0.f, 0.f, 0.f, 0.f};
        const bf16_t* ap = A + (size_t)(MP + 16 * rb + fr) * K + F.wave * kw + 8 * fq;
        const bf16_t* bp = Bt + (size_t)(64 * cb + fr) * K + F.wave * kw + 8 * fq;
        for (int s = 0; s < kw; s += 32) {
            const bf16x8 af = *(const bf16x8*)(ap + s);
#pragma unroll
            for (int n = 0; n < 4; ++n) { const bf16x8 bf = *(const bf16x8*)(bp + (size_t)16 * n * K + s); acc[n] = __builtin_amdgcn_mfma_f32_16x16x32_bf16(bf, af, acc[n], 0, 0, 0); }
        }
#pragma unroll
        for (int n = 0; n < 4; ++n) *(LAS f32x4*)(red + (F.wave * 64 + F.lane) * 16 + n * 4) = acc[n];
        __syncthreads();
        const int e = 2 * F.wave;
        f32x2 sum = (f32x2){0.f, 0.f};
#pragma unroll
        for (int w = 0; w < 8; ++w) { const f32x2 p = *(const LAS f32x2*)(red + (w * 64 + F.lane) * 16 + e); sum += p; }
        const int row = MP + 16 * rb + fr, col = 64 * cb + 16 * (e >> 2) + 4 * fq + (e & 3);
        const size_t off = (size_t)row * DM + col;
        const f32x2 xo = *(const f32x2*)(xold + off - (size_t)xoff * DM); const f32x2 xn = xo + sum * alpha;
        *(f32x2*)(xnew + off) = xn; *(unsigned*)(xb + off) = cvt_pk_bf16(xn[0], xn[1]);
        float ss = xn[0] * xn[0] + xn[1] * xn[1]; ss += __shfl_xor(ss, 16); ss += __shfl_xor(ss, 32);
        if (fq == 0) ssr[F.wave * 16 + fr] = ss;
        __syncthreads();
        if (F.tid < 16) { float s = 0.f;
#pragma unroll
            for (int w = 0; w < 8; ++w) s += ssr[w * 16 + F.tid];
            SSQ[(size_t)(MP + 16 * rb + F.tid) * 16 + cb] = s; }
        __syncthreads();
    }
}

namespace att {
typedef LAS const char* lds_cptr;
typedef short v4i16_t __attribute__((ext_vector_type(4)));
__device__ __forceinline__ int crow(int r, int hi) { return (r & 3) + 8 * (r >> 2) + 4 * hi; }
__device__ __forceinline__ void glds16(const void* gsrc, unsigned lds_dst) { unsigned keep;
    asm volatile("s_mov_b32 %0, m0\n\ts_mov_b32 m0, %2\n\ts_nop 0\n\tglobal_load_lds_dwordx4 %1, off\n\ts_mov_b32 m0, %0" : "=&s"(keep) : "v"(gsrc), "s"(lds_dst) : "memory"); }
__device__ __forceinline__ s16x4 vtr(lds_cptr p) { return __builtin_bit_cast(s16x4, __builtin_amdgcn_ds_read_tr16_b64_v4i16((LAS v4i16_t*)p)); }
#define MX3(a, b, c) __builtin_fmaxf(__builtin_fmaxf((a), (b)), (c))
__device__ __forceinline__ float rowmax32(const f32x16& p0, const f32x16& p1) {
    float a = MX3(p0[0], p0[1], p1[0]), b = MX3(p0[2], p0[3], p1[1]); a = MX3(a, p1[2], p1[3]);
#pragma unroll
    for (int r = 4; r < 16; r += 4) { a = MX3(a, p0[r], p0[r + 1]); b = MX3(b, p0[r + 2], p0[r + 3]); a = MX3(a, p1[r], p1[r + 1]); b = MX3(b, p1[r + 2], p1[r + 3]); }
    const float m = __builtin_fmaxf(a, b);
    return __builtin_fmaxf(m, __shfl_xor(m, 32));
}
#define WAIT_BAR(N) asm volatile("s_waitcnt vmcnt(" #N ") lgkmcnt(0)\n\ts_barrier" ::: "memory")
constexpr int BUFB = 32768, NBUF = 3;
constexpr int L_WSF = 98304, L_LINV = 98304 + 2048, L_BTAB = 98304 + 4096, L_MISC = 98304 + 8192;
constexpr float THR = 6.0f;

__device__ __forceinline__ void attn_unit(int b, int h, int qb, const bf16_t* Qb, const bf16_t* Kb, const bf16_t* Vb, bf16_t* MIX, const float* subln, float lam, LAS unsigned char* lds) {
    const int tid = threadIdx.x, lane = tid & 63, r32 = lane & 31, hi = lane >> 5; const int wid = __builtin_amdgcn_readfirstlane(tid >> 6);
    const int mi = wid >> 2, sub = wid & 3;
    const int q0 = qb * 128, qw = q0 + 32 * sub, NT = (q0 + 128) / 64;
    const size_t rowbase = (size_t)b * SEQ;
    const unsigned lds0 = (unsigned)(uintptr_t)lds;
    const bf16_t* ksrc0 = Kb + (rowbase + lane) * AW + (2 * h) * 64 + wid * 8;
    const bf16_t* ksrc1 = ksrc0 + 64;
    const bf16_t* vsrc0 = Vb + (rowbase + 16 * (wid & 3) + (lane >> 2)) * AW + h * 128 + (wid >> 2) * 32 + (lane & 3) * 8;
    const bf16_t* vsrc1 = vsrc0 + 64;
#define DMA_TILE(t, boff) do { const size_t go_ = (size_t)(t) * 64 * AW; const unsigned bo_ = lds0 + (boff) + wid * 1024; \
        glds16(ksrc0 + go_, (unsigned)__builtin_amdgcn_readfirstlane(bo_)); glds16(ksrc1 + go_, (unsigned)__builtin_amdgcn_readfirstlane(bo_ + 8192)); \
        glds16(vsrc0 + go_, (unsigned)__builtin_amdgcn_readfirstlane(bo_ + 16384)); glds16(vsrc1 + go_, (unsigned)__builtin_amdgcn_readfirstlane(bo_ + 16384 + 8192)); } while (0)
    VM_WAIT();
    DMA_TILE(0, 0); DMA_TILE(1, BUFB);
    bf16x8 qr[4];
    { const bf16_t* Qw = Qb + (rowbase + qw + r32) * AW + (2 * h + mi) * 64 + hi * 8;
#pragma unroll
      for (int d0 = 0; d0 < 4; ++d0) qr[d0] = *(const bf16x8*)(Qw + d0 * 16); }
    LAS float* wsf = (LAS float*)(lds + L_WSF) + wid * 64;
    const LAS float* bt = (const LAS float*)(lds + L_BTAB) + (2 * h + mi) * 128;
    const float b31 = bt[127];
    float mhat = -INFINITY, l_reg = 0.f;
    f32x16 o[4];
#pragma unroll
    for (int d = 0; d < 4; ++d) o[d] = f32x16{};
    const lds_cptr kp0 = (lds_cptr)lds + mi * 8192 + hi * 1024 + r32 * 16;
    const lds_cptr vp0 = (lds_cptr)lds + 16384 + ((lane >> 4) & 1) * 32 + (lane & 3) * 8 + (4 * hi + ((lane & 15) >> 2)) * 64;
    int sl = 0, sl2 = 2 * BUFB;
#pragma unroll 1
    for (int t = 0; t < NT; ++t) {
        if (t + 1 < NT) WAIT_BAR(4); else WAIT_BAR(0);
        if (t + 2 < NT) DMA_TILE(t + 2, sl2);
        const int k0 = 64 * t;
        if (k0 <= qw + 31) {
            f32x16 p0 = f32x16{}, p1 = f32x16{};
#pragma unroll
            for (int d0 = 0; d0 < 4; ++d0) {
                const bf16x8 k0f = *(const LAS bf16x8*)(kp0 + sl + d0 * 2048), k1f = *(const LAS bf16x8*)(kp0 + sl + d0 * 2048 + 512);
                p0 = __builtin_amdgcn_mfma_f32_32x32x16_bf16(k0f, qr[d0], p0, 0, 0, 0); p1 = __builtin_amdgcn_mfma_f32_32x32x16_bf16(k1f, qr[d0], p1, 0, 0, 0);
            }
            float cadd = b31;
            if (k0 + 63 > qw - 113) {
                cadd = 0.f; const int dq = qw + r32 - k0 - 4 * hi;
#pragma unroll
                for (int r = 0; r < 16; ++r) { const int d0_ = dq - ((r & 3) + 8 * (r >> 2)), d1_ = d0_ - 32;
                    p0[r] = (d0_ < 0) ? -INFINITY : p0[r] + bt[d0_ > 127 ? 127 : d0_];
                    p1[r] = (d1_ < 0) ? -INFINITY : p1[r] + bt[d1_ > 127 ? 127 : d1_]; }
            }
            const float rm = rowmax32(p0, p1) + cadd;
            if (__any(rm > mhat + THR)) {
                const float mnew = __builtin_fmaxf(mhat, rm); const float f = __builtin_amdgcn_exp2f(mhat - mnew); mhat = mnew; l_reg *= f;
                if (hi == 0) wsf[r32] = f;
                LDS_WAIT();
#pragma unroll
                for (int r = 0; r < 16; ++r) { const float fr_ = wsf[crow(r, hi)];
#pragma unroll
                    for (int d = 0; d < 4; ++d) o[d][r] *= fr_; }
            }
            const float nm = cadd - mhat; float sacc = 0.f;
#pragma unroll
            for (int r = 0; r < 16; ++r) { p0[r] = __builtin_amdgcn_exp2f(p0[r] + nm); p1[r] = __builtin_amdgcn_exp2f(p1[r] + nm); sacc += p0[r] + p1[r]; }
            l_reg += sacc;
            u32x4 pw[4];
#pragma unroll
            for (int j = 0; j < 4; ++j) { pw[0][j] = cvt_pk_bf16(p0[2 * j], p0[2 * j + 1]); pw[1][j] = cvt_pk_bf16(p0[8 + 2 * j], p0[8 + 2 * j + 1]);
                                          pw[2][j] = cvt_pk_bf16(p1[2 * j], p1[2 * j + 1]); pw[3][j] = cvt_pk_bf16(p1[8 + 2 * j], p1[8 + 2 * j + 1]); }
#pragma unroll
            for (int ks = 0; ks < 4; ++ks)
#pragma unroll
                for (int d = 0; d < 4; ++d) {
                    const s16x4 lo = vtr(vp0 + sl + d * 4096 + ks * 1024), hh = vtr(vp0 + sl + d * 4096 + ks * 1024 + 512);
                    const bf16x8 vf = (bf16x8){lo[0], lo[1], lo[2], lo[3], hh[0], hh[1], hh[2], hh[3]};
                    o[d] = __builtin_amdgcn_mfma_f32_32x32x16_bf16(__builtin_bit_cast(bf16x8, pw[ks]), vf, o[d], 0, 0, 0);
                }
        }
        sl = (sl == 2 * BUFB) ? 0 : sl + BUFB; sl2 = (sl2 == 2 * BUFB) ? 0 : sl2 + BUFB;
    }
    l_reg += __shfl_xor(l_reg, 32);
    WAIT_BAR(0);
    LAS float* linv = (LAS float*)(lds + L_LINV);
    if (hi == 0) linv[(mi * 4 + sub) * 32 + r32] = l_reg;
    LAS float* stg = (LAS float*)lds + sub * 4096;
    if (mi == 1) {
#pragma unroll
        for (int r = 0; r < 16; ++r)
#pragma unroll
            for (int d = 0; d < 4; ++d) stg[crow(r, hi) * 128 + d * 32 + r32] = o[d][r];
    }
    WAIT_BAR(0);
    if (mi == 0) {
        float sg[4];
#pragma unroll
        for (int d = 0; d < 4; ++d) sg[d] = subln[d * 32 + r32] * (1.f - LAM_INIT);
        bf16_t* dst = MIX + (rowbase + qw) * DM + h * 128 + r32;
#pragma unroll
        for (int r = 0; r < 16; ++r) { const int row = crow(r, hi);
            const float a = __builtin_amdgcn_rcpf(linv[sub * 32 + row]), bq = lam * __builtin_amdgcn_rcpf(linv[(4 + sub) * 32 + row]);
            float v[4]; float ss = 0.f;
#pragma unroll
            for (int d = 0; d < 4; ++d) { v[d] = o[d][r] * a - bq * stg[row * 128 + d * 32 + r32]; ss += v[d] * v[d]; }
            ss += __shfl_xor(ss, 1); ss += __shfl_xor(ss, 2); ss += __shfl_xor(ss, 4); ss += __shfl_xor(ss, 8); ss += __shfl_xor(ss, 16);
            const float sc = __builtin_amdgcn_rsqf(ss * (1.f / 128.f) + EPS);
#pragma unroll
            for (int d = 0; d < 4; ++d) dst[(size_t)row * DM + d * 32] = (bf16_t)(cvt_pk_bf16(v[d] * sc * sg[d], 0.f) & 0xffffu);
        }
    }
    WAIT_BAR(0);
#undef DMA_TILE
}

__device__ __forceinline__ void spatial_unit(int c, int g, const bf16_t* GVb, const bf16_t* Ub, const bf16_t* WT, const float* bs, bf16_t* MIX, LAS unsigned char* lds) {
    const int tid = threadIdx.x, lane = tid & 63, r32 = lane & 31, hi = lane >> 5; const int wid = __builtin_amdgcn_readfirstlane(tid >> 6);
    const int ib = wid & 3, chh = wid >> 2;
    const unsigned lds0 = (unsigned)(uintptr_t)lds;
    const size_t row0 = (size_t)c * 128;
    VM_WAIT();
#pragma unroll
    for (int j = 0; j < 4; ++j) { const int p = wid + 8 * j, jt = p >> 4, db = (p >> 2) & 3, kg = p & 3;
        const bf16_t* src = GVb + (row0 + 64 * jt + 16 * kg + (lane >> 2)) * AW + g * 128 + db * 32 + (lane & 3) * 8;
        glds16(src, (unsigned)__builtin_amdgcn_readfirstlane(lds0 + jt * 16384 + (db * 4 + kg) * 1024)); }
    f32x16 o[2]; o[0] = f32x16{}; o[1] = f32x16{};
    const bf16_t* wrow = WT + ((size_t)g * 128 + 32 * ib + r32) * 128 + 4 * hi;
    WAIT_BAR(0);
    const lds_cptr vp0 = (lds_cptr)lds + ((lane >> 4) & 1) * 32 + (lane & 3) * 8 + (4 * hi + ((lane & 15) >> 2)) * 64;
#pragma unroll 1
    for (int ks = 0; ks < 2 * ib + 2; ++ks) {
        const u32x2 a0 = *(const u32x2*)(wrow + 16 * ks), a1 = *(const u32x2*)(wrow + 16 * ks + 8);
        const u32x4 aw = (u32x4){a0.x, a0.y, a1.x, a1.y};
        const int jt = ks >> 2, kk = ks & 3;
#pragma unroll
        for (int d = 0; d < 2; ++d) { const int db = 2 * chh + d;
            const s16x4 lo = vtr(vp0 + jt * 16384 + db * 4096 + kk * 1024), hh = vtr(vp0 + jt * 16384 + db * 4096 + kk * 1024 + 512);
            const bf16x8 vf = (bf16x8){lo[0], lo[1], lo[2], lo[3], hh[0], hh[1], hh[2], hh[3]};
            o[d] = __builtin_amdgcn_mfma_f32_32x32x16_bf16(__builtin_bit_cast(bf16x8, aw), vf, o[d], 0, 0, 0); }
    }
#pragma unroll
    for (int r = 0; r < 16; ++r) { const int i = 32 * ib + crow(r, hi); const float bi = bs[g * 128 + i];
#pragma unroll
        for (int d = 0; d < 2; ++d) { const int ch = g * 128 + (2 * chh + d) * 32 + r32;
            const float uu = bf2f(Ub[(row0 + i) * AW + ch]);
            MIX[(row0 + i) * DM + 512 + ch] = (bf16_t)(cvt_pk_bf16(uu * (o[d][r] + bi), 0.f) & 0xffffu); } }
    WAIT_BAR(0);
}

__device__ __forceinline__ void sample_stream_unit(int b, int h, int half, const float* ck, const float* cv, const int* pt, const bf16_t* Qb, float* spart, LAS unsigned char* lds) {
    const int tid = threadIdx.x, lane = tid & 63, fr = lane & 15, fq = lane >> 4; const int wid = __builtin_amdgcn_readfirstlane(tid >> 6);
    LAS float* P = (LAS float*)(lds + wid * 4096);
    LAS float* Fv = P + 512;
    const LAS float* btl = (const LAS float*)(lds + L_BTAB);
    LAS float* part = (LAS float*)(lds + 32768);
    bf16x8 qf[2][2];
#pragma unroll
    for (int mi = 0; mi < 2; ++mi)
#pragma unroll
        for (int kk = 0; kk < 2; ++kk) { bf16x8 z = (bf16x8){0, 0, 0, 0, 0, 0, 0, 0};
            if (fr < 8) z = *(const bf16x8*)(Qb + (size_t)(MP + b * 8 + fr) * AW + (2 * h + mi) * 64 + 32 * kk + 8 * fq);
            qf[mi][kk] = z; }
    float m[2] = {-INFINITY, -INFINITY}, ls[2] = {0.f, 0.f};
    f32x2 o[16];
#pragma unroll
    for (int i = 0; i < 16; ++i) o[i] = (f32x2){0.f, 0.f};
#pragma unroll 1
    for (int pg = 0; pg < 4; ++pg) {
        const int pgi = half * 32 + wid * 4 + pg; const int pid = __builtin_amdgcn_readfirstlane(pt[b * NPAGES + pgi]);
#pragma unroll 1
        for (int bt_ = 0; bt_ < 4; ++bt_) {
            const size_t krow0 = (size_t)pid * PAGE + bt_ * 32; const int kpos0 = pgi * PAGE + bt_ * 32;
            f32x4 kr[2][2][2][2];
#pragma unroll
            for (int kb = 0; kb < 2; ++kb)
#pragma unroll
                for (int mi = 0; mi < 2; ++mi)
#pragma unroll
                    for (int kk = 0; kk < 2; ++kk) { const f32x4* p = (const f32x4*)(ck + (krow0 + 16 * kb + fr) * AW + (2 * h + mi) * 64 + 32 * kk + 8 * fq); kr[kb][mi][kk][0] = p[0]; kr[kb][mi][kk][1] = p[1]; }
            f32x2 vv[16];
#pragma unroll
            for (int k = 0; k < 16; ++k) vv[k] = *(const f32x2*)(cv + (krow0 + k) * AW + h * 128 + 2 * lane);
            f32x4 s[2][2];
#pragma unroll
            for (int kb = 0; kb < 2; ++kb)
#pragma unroll
                for (int mi = 0; mi < 2; ++mi) { f32x4 a = (f32x4){0.f, 0.f, 0.f, 0.f};
#pragma unroll
                    for (int kk = 0; kk < 2; ++kk) { const f32x4 x = kr[kb][mi][kk][0], y = kr[kb][mi][kk][1];
                        u32x4 w; w.x = cvt_pk_bf16(x[0], x[1]); w.y = cvt_pk_bf16(x[2], x[3]); w.z = cvt_pk_bf16(y[0], y[1]); w.w = cvt_pk_bf16(y[2], y[3]);
                        a = __builtin_amdgcn_mfma_f32_16x16x32_bf16(__builtin_bit_cast(bf16x8, w), qf[mi][kk], a, 0, 0, 0); }
                    s[kb][mi] = a; }
#pragma unroll
            for (int mi = 0; mi < 2; ++mi) { const LAS float* bt = btl + (2 * h + mi) * 128;
                if (kpos0 > 8048) {
#pragma unroll
                    for (int kb = 0; kb < 2; ++kb)
#pragma unroll
                        for (int j = 0; j < 4; ++j) { int d = SEQ + fr - (kpos0 + 16 * kb + 4 * fq + j); d = d > 127 ? 127 : d; s[kb][mi][j] += bt[d]; }
                } else { const float b31 = bt[127]; s[0][mi] += b31; s[1][mi] += b31; }
            }
            float fsc[2];
#pragma unroll
            for (int mi = 0; mi < 2; ++mi) {
                float bm = __builtin_fmaxf(MX3(s[0][mi][0], s[0][mi][1], s[0][mi][2]), MX3(s[0][mi][3], s[1][mi][0], s[1][mi][1])); bm = MX3(bm, s[1][mi][2], s[1][mi][3]);
                bm = __builtin_fmaxf(bm, __shfl_xor(bm, 16)); bm = __builtin_fmaxf(bm, __shfl_xor(bm, 32));
                const float mnew = __builtin_fmaxf(m[mi], bm); fsc[mi] = __builtin_amdgcn_exp2f(m[mi] - mnew); m[mi] = mnew; ls[mi] *= fsc[mi];
#pragma unroll
                for (int kb = 0; kb < 2; ++kb)
#pragma unroll
                    for (int j = 0; j < 4; ++j) { const float p = __builtin_amdgcn_exp2f(s[kb][mi][j] - mnew); ls[mi] += p; if (fr < 8) P[(16 * kb + 4 * fq + j) * 16 + mi * 8 + fr] = p; }
                if (fr < 8 && fq == 0) Fv[mi * 8 + fr] = fsc[mi];
            }
            LDS_WAIT(); asm volatile("" ::: "memory");
            { const LAS f32x4* fp = (const LAS f32x4*)Fv; const f32x4 f0 = fp[0], f1 = fp[1], f2 = fp[2], f3 = fp[3];
#pragma unroll
              for (int j = 0; j < 4; ++j) { o[j] *= f0[j]; o[4 + j] *= f1[j]; o[8 + j] *= f2[j]; o[12 + j] *= f3[j]; } }
            f32x2 vw[16];
#pragma unroll
            for (int k = 0; k < 16; ++k) vw[k] = *(const f32x2*)(cv + (krow0 + 16 + k) * AW + h * 128 + 2 * lane);
#pragma unroll
            for (int k = 0; k < 16; ++k) { const LAS f32x4* pp = (const LAS f32x4*)(P + k * 16); const f32x4 p0 = pp[0], p1 = pp[1], p2 = pp[2], p3 = pp[3];
#pragma unroll
                for (int j = 0; j < 4; ++j) { o[j] += vv[k] * p0[j]; o[4 + j] += vv[k] * p1[j]; o[8 + j] += vv[k] * p2[j]; o[12 + j] += vv[k] * p3[j]; } }
#pragma unroll
            for (int k = 0; k < 16; ++k) { const LAS f32x4* pp = (const LAS f32x4*)(P + (16 + k) * 16); const f32x4 p0 = pp[0], p1 = pp[1], p2 = pp[2], p3 = pp[3];
#pragma unroll
                for (int j = 0; j < 4; ++j) { o[j] += vw[k] * p0[j]; o[4 + j] += vw[k] * p1[j]; o[8 + j] += vw[k] * p2[j]; o[12 + j] += vw[k] * p3[j]; } }
            LDS_WAIT(); asm volatile("" ::: "memory");
        }
    }
#pragma unroll
    for (int mi = 0; mi < 2; ++mi) { float l = ls[mi]; l += __shfl_xor(l, 16); l += __shfl_xor(l, 32);
        if (fr < 8 && fq == 0) { part[wid * SPART_F + mi * 8 + fr] = m[mi]; part[wid * SPART_F + 16 + mi * 8 + fr] = l; } }
#pragma unroll
    for (int i = 0; i < 16; ++i) *(LAS f32x2*)(part + wid * SPART_F + 32 + i * 128 + 2 * lane) = o[i];
    __syncthreads();
    { const int d = tid & 127, qg = tid >> 7; float* dst = spart + (size_t)((b * 4 + h) * 2 + half) * SPART_F;
#pragma unroll
      for (int e = 0; e < 4; ++e) { const int qm = qg * 4 + e; float mx = -INFINITY;
#pragma unroll
          for (int w = 0; w < 8; ++w) mx = __builtin_fmaxf(mx, part[w * SPART_F + qm]);
          float a = 0.f, l = 0.f;
#pragma unroll
          for (int w = 0; w < 8; ++w) { const float f = __builtin_amdgcn_exp2f(part[w * SPART_F + qm] - mx); a += f * part[w * SPART_F + 32 + qm * 128 + d]; l += f * part[w * SPART_F + 16 + qm]; }
          dst[32 + qm * 128 + d] = a; if (d == 0) { dst[qm] = mx; dst[16 + qm] = l; } } }
    __syncthreads();
}

__device__ __forceinline__ void sample_combine(int b, int h, const float* spart, const bf16_t* Qb, const bf16_t* Kb, const bf16_t* Vb, bf16_t* MIX, const float* subln, float lam, LAS unsigned char* lds) {
    const int tid = threadIdx.x, lane = tid & 63;
    LAS float* SN = (LAS float*)lds;
    LAS float* W0 = SN + 128, *W1 = W0 + 16, *LI = W1 + 16, *PJ = LI + 16;
    const LAS float* btl = (const LAS float*)(lds + L_BTAB);
    const float* s0 = spart + (size_t)((b * 4 + h) * 2) * SPART_F; const float* s1 = s0 + SPART_F;
    if (tid < 128) { const int mi = tid >> 6, q = (tid >> 3) & 7, j = tid & 7; float s = -INFINITY;
        if (j <= q) { const bf16_t* qp = Qb + (size_t)(MP + b * 8 + q) * AW + (2 * h + mi) * 64; const bf16_t* kp = Kb + (size_t)(MP + b * 8 + j) * AW + (2 * h + mi) * 64; float a = 0.f;
            for (int d = 0; d < 64; ++d) a += bf2f(qp[d]) * bf2f(kp[d]);
            s = a + btl[(2 * h + mi) * 128 + (q - j)]; }
        SN[(mi * 8 + q) * 8 + j] = s; }
    __syncthreads();
    if (tid < 16) { const int qm = tid; float mx = __builtin_fmaxf(s0[qm], s1[qm]);
        for (int j = 0; j < 8; ++j) mx = __builtin_fmaxf(mx, SN[qm * 8 + j]);
        const float w0 = __builtin_amdgcn_exp2f(s0[qm] - mx), w1 = __builtin_amdgcn_exp2f(s1[qm] - mx); float l = w0 * s0[16 + qm] + w1 * s1[16 + qm];
        for (int j = 0; j < 8; ++j) { const float p = __builtin_amdgcn_exp2f(SN[qm * 8 + j] - mx); PJ[qm * 8 + j] = p; l += p; }
        W0[qm] = w0; W1[qm] = w1; LI[qm] = 1.f / l; }
    __syncthreads();
    { const int q = tid >> 6, d = 2 * lane; float v[2];
#pragma unroll
      for (int e = 0; e < 2; ++e) { float om[2];
#pragma unroll
          for (int mi = 0; mi < 2; ++mi) { const int qm = mi * 8 + q; float a = W0[qm] * s0[32 + qm * 128 + d + e] + W1[qm] * s1[32 + qm * 128 + d + e];
              for (int j = 0; j <= q; ++j) a += PJ[qm * 8 + j] * bf2f(Vb[(size_t)(MP + b * 8 + j) * AW + h * 128 + d + e]);
              om[mi] = a * LI[qm]; }
          v[e] = om[0] - lam * om[1]; }
      const float ss = wave_sum(v[0] * v[0] + v[1] * v[1]); const float sc = __builtin_amdgcn_rsqf(ss * (1.f / 128.f) + EPS) * (1.f - LAM_INIT);
      *(unsigned*)(MIX + (size_t)(MP + b * 8 + q) * DM + h * 128 + d) = cvt_pk_bf16(v[0] * sc * subln[d], v[1] * sc * subln[d + 1]); }
    __syncthreads();
}
#undef MX3
#undef WAIT_BAR
}

__global__ void __launch_bounds__(NWAVES * 64, 2) mega_fwd(Args args) {
    extern __shared__ __attribute__((aligned(16))) unsigned char lds_raw[];
    Frame F;
    F.lds = (LAS unsigned char*)lds_raw;
    F.MISC = (volatile LAS unsigned*)(F.lds + MISC_OFF);
    F.tid = threadIdx.x; F.lane = F.tid & 63; F.wave = __builtin_amdgcn_readfirstlane(F.tid >> 6);
    F.G = gridDim.x; { const int bx = blockIdx.x; F.vcu = (F.G % 8 == 0) ? (bx % 8) * (F.G / 8) + bx / 8 : bx; }
    F.ws = args.ws; F.out = args.out; F.ctl = (unsigned*)(args.ws + WS_CTL);
    for (int u = F.tid; u < (LDS_BYTES - LDSCTL_OFF) / 4; u += NWAVES * 64) ((LAS unsigned*)(F.lds + LDSCTL_OFF))[u] = 0u;
    __syncthreads();
    XcdBarrier bar; bar.bar = F.ctl + CW_BAR + args.li * XCD_BAR_WORDS; bar.x = 0; bar.st = nullptr;
    if (N_LAUNCHES != PER_PHASE) bar = xcd_barrier_post(F.ctl + CW_BAR + args.li * XCD_BAR_WORDS, F.MISC + 8);
#define GRID_BAR() do { if (N_LAUNCHES != PER_PHASE) xcd_barrier(bar); } while (0)
    const int lo = args.ph_lo, hi = args.ph_hi;
#define IN(k) (lo <= (k) && (k) < hi)
#define BOTH(k) (IN(k) && IN((k) + 1))
    bf16_t* XB = (bf16_t*)(F.ws + WS_XB); bf16_t* Hb = (bf16_t*)(F.ws + WS_H); bf16_t* MIXb = (bf16_t*)(F.ws + WS_MIX);
    bf16_t *Qb = (bf16_t*)(F.ws + WS_Q), *Kb = (bf16_t*)(F.ws + WS_K), *Vb = (bf16_t*)(F.ws + WS_V), *Ub = (bf16_t*)(F.ws + WS_U), *GVb = (bf16_t*)(F.ws + WS_GV);
    float* X1 = (float*)(F.ws + WS_X1); float* SSQ = (float*)(F.ws + WS_SSQ);
    const LAS float* rstab = (const LAS float*)(F.lds + RSTAB_OFF);

    if (IN(0)) { p0_prologue(F, args); if (BOTH(0)) GRID_BAR(); }
    if (IN(1)) {
        pg8::Gemm g{XB, (const bf16_t*)(F.ws + WS_WGU1), MT, NGU, DM}; pg8::StaticOrder S; S.init(MT, NGU, F.G, (int)blockIdx.x);
        rstab_fill(F, S);
        pg8::EpiSwiGLU E{Hb, rstab};
        pg8::gemm_phase<pg8::EpiSwiGLU, pg8::StaticOrder, true, true>(F.lds, g, S, E);
        if (BOTH(1)) GRID_BAR();
    }
    if (IN(2)) {
        pg8::Gemm g{Hb, (const bf16_t*)(F.ws + WS_WD1), MP, DM, DFF}; pg8::StaticOrder S; S.init(MP, DM, F.G, (int)blockIdx.x);
        pg8::EpiResid E{args.in[I_XP], X1, XB, SSQ, 0.5f};
        pg8::gemm_phase<pg8::EpiResid, pg8::StaticOrder, true, true>(F.lds, g, S, E);
        mini_gemm_resid(F, Hb, (const bf16_t*)(F.ws + WS_WD1), DFF, args.in[I_XS], MP, X1, XB, 0.5f);
        if (BOTH(2)) GRID_BAR();
    }
    if (IN(3)) {
        pg8::Gemm g{XB, (const bf16_t*)(F.ws + WS_WIN), MT, NIN, DM}; pg8::StaticOrder S; S.init(MT, NIN, F.G, (int)blockIdx.x);
        rstab_fill(F, S);
        pg8::EpiWin E{Qb, Kb, Vb, Ub, GVb, F.out, args.in[I_GNORM], rstab, (LAS float*)(F.lds + GX_OFF)};
        pg8::gemm_phase<pg8::EpiWin, pg8::StaticOrder, true, true>(F.lds, g, S, E);
        if (BOTH(3)) GRID_BAR();
    }
    if (IN(4)) {
        { const float* BT = (const float*)(F.ws + WS_BTAB); LAS float* btl = (LAS float*)(F.lds + att::L_BTAB); for (int e = F.tid; e < 1024; e += 512) btl[e] = BT[e]; }
        __syncthreads();
        for (int u = F.vcu; u < 256; u += F.G) att::sample_stream_unit(u >> 3, (u >> 1) & 3, u & 1, args.in[I_CK], args.in[I_CV], args.page_table, Qb, (float*)(F.ws + WS_SPART), F.lds);
        for (int u = F.vcu; u < 512; u += F.G) att::spatial_unit(u >> 2, u & 3, GVb, Ub, (const bf16_t*)(F.ws + WS_WTRIL), args.in[I_BS], MIXb, F.lds);
        for (int e = F.vcu * 512 + F.tid; e < MS * AW; e += F.G * 512) { const int r = e >> 9, ch = e & 511, g = ch >> 7, i = r & 7, bb = r >> 3; float a = args.in[I_BS][g * 128 + i];
            for (int j = 0; j <= i; ++j) a += args.in[I_WS][(g * 128 + i) * 128 + j] * F.out[O_GS + (size_t)(bb * 8 + j) * AW + ch];
            const float uu = bf2f(Ub[(size_t)(MP + r) * AW + ch]);
            MIXb[(size_t)(MP + r) * DM + 512 + ch] = (bf16_t)(cvt_pk_bf16(uu * a, 0.f) & 0xffffu); }
        if (BOTH(4)) GRID_BAR();
    }
    if (IN(5)) {
        float lam;
        { const float a = wave_sum(args.in[I_LQ1][F.lane] * args.in[I_LK1][F.lane]), c = wave_sum(args.in[I_LQ2][F.lane] * args.in[I_LK2][F.lane]); lam = __expf(a) - __expf(c) + LAM_INIT; }
        { const float* BT = (const float*)(F.ws + WS_BTAB); LAS float* btl = (LAS float*)(F.lds + att::L_BTAB); for (int e = F.tid; e < 1024; e += 512) btl[e] = BT[e]; }
        __syncthreads();
        for (int u = F.vcu; u < 128; u += F.G) att::sample_combine(u >> 2, u & 3, (const float*)(F.ws + WS_SPART), Qb, Kb, Vb, MIXb, args.in[I_SUBLN], lam, F.lds);
        for (int u = F.vcu; u < 256; u += F.G) { const int bh = u >> 5, s = u & 31;
            att::attn_unit(bh >> 2, bh & 3, 63 - s, Qb, Kb, Vb, MIXb, args.in[I_SUBLN], lam, F.lds);
            att::attn_unit(bh >> 2, bh & 3, s, Qb, Kb, Vb, MIXb, args.in[I_SUBLN], lam, F.lds); }
        if (BOTH(5)) GRID_BAR();
    }
    if (IN(6)) {
        pg8::Gemm g{MIXb, (const bf16_t*)(F.ws + WS_WOUT), MP, DM, DM}; pg8::StaticOrder S; S.init(MP, DM, F.G, (int)blockIdx.x);
        pg8::EpiResid E{X1, X1, XB, SSQ, 1.0f};
        pg8::gemm_phase<pg8::EpiResid, pg8::StaticOrder, true, true>(F.lds, g, S, E);
        mini_gemm_resid(F, MIXb, (const bf16_t*)(F.ws + WS_WOUT), DM, X1, 0, X1, XB, 1.0f);
        if (BOTH(6)) GRID_BAR();
    }
    if (IN(7)) {
        pg8::Gemm g{XB, (const bf16_t*)(F.ws + WS_WGU2), MT, NGU, DM}; pg8::StaticOrder S; S.init(MT, NGU, F.G, (int)blockIdx.x);
        rstab_fill(F, S);
        pg8::EpiSwiGLU E{Hb, rstab};
        pg8::gemm_phase<pg8::EpiSwiGLU, pg8::StaticOrder, true, true>(F.lds, g, S, E);
        if (BOTH(7)) GRID_BAR();
    }
    if (IN(8)) {
        pg8::Gemm g{Hb, (const bf16_t*)(F.ws + WS_WD2), MP, DM, DFF}; pg8::StaticOrder S; S.init(MP, DM, F.G, (int)blockIdx.x);
        pg8::EpiResid E{X1, F.out, XB, SSQ, 0.5f};
        pg8::gemm_phase<pg8::EpiResid, pg8::StaticOrder, true, true>(F.lds, g, S, E);
        mini_gemm_resid(F, Hb, (const bf16_t*)(F.ws + WS_WD2), DFF, X1, 0, F.out, XB, 0.5f);
        if (BOTH(8)) GRID_BAR();
    }
    if (IN(9)) {
        const unsigned bad = (N_LAUNCHES != PER_PHASE) ? __hip_atomic_load(F.ctl + CW_BAR + XB_TMO, __ATOMIC_RELAXED, __HIP_MEMORY_SCOPE_AGENT) : 0u;
        const int gw = F.vcu * NWAVES + F.wave, NGW = F.G * NWAVES; const float* gf = args.in[I_NFIN];
        const int ln9 = (int)__builtin_amdgcn_mbcnt_hi(~0u, __builtin_amdgcn_mbcnt_lo(~0u, 0u));
        for (int m = gw; m < MT; m += NGW) {
            const f32x4* p = (const f32x4*)(SSQ + (size_t)m * 16); const f32x4 s4 = (p[0] + p[1]) + (p[2] + p[3]);
            float rs = __builtin_amdgcn_rsqf(((s4[0] + s4[1]) + (s4[2] + s4[3])) * (1.f / DM) + EPS);
            if (bad) rs = __builtin_nanf("");
            f32x4* xr = (f32x4*)(F.out + (size_t)m * DM) + ln9;
#pragma unroll
            for (int j = 0; j < 4; ++j) { const f32x4 gg = ((const f32x4*)gf)[ln9 + 64 * j]; xr[64 * j] = xr[64 * j] * rs * gg; }
        }
    }
#undef IN
#undef BOTH
#undef GRID_BAR
}

extern "C" void kernel_launch(void* const* d_in, const int* in_sizes, int n_in, void* d_out, int out_size, void* d_ws, size_t ws_size, hipStream_t stream) {
    static int grid = 0;
    if (grid == 0) {
        if (n_in != 24 || (size_t)out_size != O_END || ws_size < WS_END) { fprintf(stderr, "kernel_launch: unexpected sizes (n_in %d out %d ws %zu)\n", n_in, out_size, ws_size); grid = -1; return; }
        int dev = 0, cus = 0, per_cu = 0;
        if (hipGetDevice(&dev) != hipSuccess || hipDeviceGetAttribute(&cus, hipDeviceAttributeMultiprocessorCount, dev) != hipSuccess) { grid = -1; return; }
        if (hipFuncSetAttribute((const void*)mega_fwd, hipFuncAttributeMaxDynamicSharedMemorySize, LDS_BYTES) != hipSuccess) { fprintf(stderr, "kernel_launch: hipFuncSetAttribute failed\n"); grid = -1; return; }
        if (hipOccupancyMaxActiveBlocksPerMultiprocessor(&per_cu, (const void*)mega_fwd, NWAVES * 64, LDS_BYTES) != hipSuccess || per_cu < 1) { fprintf(stderr, "kernel_launch: occupancy query reports %d\n", per_cu); }
        (void)hipGetLastError();
        grid = cus;
        if (grid != 256) { fprintf(stderr, "kernel_launch: built for 256 CUs, found %d\n", cus); grid = -1; return; }
    }
    if (grid < 0) return;
    if (hipMemsetAsync((char*)d_ws + WS_CTL, 0, CTL_ZERO_BYTES, stream) != hipSuccess) return;
    Args a{};
    for (int i = 0; i < 24; ++i) a.in[i] = (const float*)d_in[i];
    a.page_table = (const int*)d_in[I_PT]; a.out = (float*)d_out; a.ws = (unsigned char*)d_ws;
    if (N_LAUNCHES == 1) { a.ph_lo = 0; a.ph_hi = PER_PHASE; a.li = 0; hipLaunchKernelGGL(mega_fwd, dim3(grid), dim3(NWAVES * 64), LDS_BYTES, stream, a); }
    else { for (int li = 0; li < PER_PHASE; ++li) { a.ph_lo = li; a.ph_hi = li + 1; a.li = 0; hipLaunchKernelGGL(mega_fwd, dim3(grid), dim3(NWAVES * 64), LDS_BYTES, stream, a); } }
    const hipError_t le = hipPeekAtLastError();
    if (le != hipSuccess) fprintf(stderr, "kernel_launch: launch failed: %s\n", hipGetErrorName(le));
}
```

```cpp
#include <hip/hip_runtime.h>
#include <cstdio>
#include <cstdint>

#define LAS __attribute__((address_space(3)))
#define GAS __attribute__((address_space(1)))
typedef unsigned short bf16_t;
typedef short bf16x8 __attribute__((ext_vector_type(8)));
typedef short s16x4 __attribute__((ext_vector_type(4)));
typedef float f32x2 __attribute__((ext_vector_type(2)));
typedef float f32x4 __attribute__((ext_vector_type(4)));
typedef float f32x16 __attribute__((ext_vector_type(16)));
typedef unsigned u32x2 __attribute__((ext_vector_type(2)));
typedef unsigned u32x4 __attribute__((ext_vector_type(4)));

constexpr int DM = 1024, SEQ = 8192, MP = 16384, MS = 256, MT = 16640, DFF = 2816, NGU = 5632, NIN = 2560, AW = 512;
constexpr int NPAGES = 64, PAGE = 128;
constexpr float EPS = 1e-6f, LOG2E = 1.4426950408889634f, C2 = 0.125f * 1.4426950408889634f;
constexpr float LAM_INIT = 0.2f;
constexpr int NWAVES = 8;
#ifndef MK_N_LAUNCHES
#define MK_N_LAUNCHES 1
#endif
constexpr int N_LAUNCHES = MK_N_LAUNCHES;
constexpr int PER_PHASE = 9;

constexpr size_t O_Y = 0, O_KP = (size_t)MT * DM, O_VP = O_KP + (size_t)MP * AW, O_KS = O_VP + (size_t)MP * AW, O_VS = O_KS + (size_t)MS * AW, O_GS = O_VS + (size_t)MS * AW, O_END = O_GS + (size_t)MS * AW;

constexpr size_t MiB = 1u << 20;
constexpr size_t WS_CTL = 0, CTL_ZERO_BYTES = 1 * MiB;
constexpr size_t WS_WGU1 = 2 * MiB, WS_WD1 = 13 * MiB, WS_WIN = 19 * MiB, WS_WOUT = 24 * MiB, WS_WGU2 = 26 * MiB, WS_WD2 = 37 * MiB;
constexpr size_t WS_WTRIL = 43 * MiB, WS_BTAB = 43 * MiB + 256 * 1024, WS_SSQ = 44 * MiB, WS_SPART = 46 * MiB;
constexpr size_t WS_XB = 64 * MiB, WS_Q = 100 * MiB, WS_K = 120 * MiB, WS_V = 140 * MiB, WS_U = 160 * MiB, WS_GV = 180 * MiB, WS_MIX = 200 * MiB;
constexpr size_t WS_X1 = 240 * MiB, WS_H = 320 * MiB, WS_END = 416 * MiB;
constexpr int CW_TMO = 0, CW_BAR = 4096, CW_Q = 16384;
constexpr int SPART_F = 16 + 16 + 16 * 128;

constexpr int RING_BYTES = 131072;
constexpr int LDSCTL_OFF = RING_BYTES, MISC_OFF = LDSCTL_OFF + 320;
constexpr int RSTAB_OFF = RING_BYTES + 512;
constexpr int GX_OFF = RSTAB_OFF + 6144;
constexpr int LDS_BYTES = 147456;
static_assert(GX_OFF + 8192 <= LDS_BYTES, "LDS map");

__device__ __forceinline__ unsigned cvt_pk_bf16(float lo, float hi) { unsigned r; asm("v_cvt_pk_bf16_f32 %0, %1, %2" : "=v"(r) : "v"(lo), "v"(hi)); return r; }
__device__ __forceinline__ float bf2f(bf16_t v) { return __uint_as_float((unsigned)v << 16); }
__device__ __forceinline__ float silu_f(float x) { return x * __builtin_amdgcn_rcpf(1.f + __builtin_amdgcn_exp2f(-x * LOG2E)); }
__device__ __forceinline__ float gelu_f(float x) { const float z2 = x * (1.5957691216f + 0.0713548163f * x * x); return x * __builtin_amdgcn_rcpf(1.f + __builtin_amdgcn_exp2f(-z2 * LOG2E)); }
__device__ __forceinline__ float wave_sum(float v) {
#pragma unroll
    for (int o = 1; o < 64; o <<= 1) v += __shfl_xor(v, o);
    return v;
}
#define LDS_WAIT() asm volatile("s_waitcnt lgkmcnt(0)" ::: "memory")
#define VM_WAIT() asm volatile("s_waitcnt vmcnt(0)" ::: "memory")

namespace pg8 {
constexpr int BM = 256, BK = 64, HALF = 128, HTB = HALF * BK * 2, STAGE_BYTES = 8 * HTB, NXCD = 8, WGM = 8;
__host__ __device__ __forceinline__ int lds_byte(int r, int c) { const int st = (r >> 4) * 2 + (c >> 5), rr = r & 15, cc = c & 31, ob = rr * 64 + cc * 2; return st * 1024 + (ob ^ (((ob >> 9) & 1) << 5)); }
__host__ __device__ __forceinline__ void stage_rc(int b, int& R, int& C) { const int st = b / 1024, sb = b % 1024, swz = sb ^ (((sb >> 9) & 1) << 5); R = (st >> 1) * 16 + swz / 64; C = (st & 1) * 32 + (swz % 64) / 2; }
__host__ __device__ __forceinline__ int perm32(int rho) { const int n = rho >> 4, i = rho & 15; return 8 * (i >> 2) + 4 * n + (i & 3); }

struct Unit { int pm, pn, idx; };
struct Gemm { const bf16_t* A; const bf16_t* Bt; int M, N, K; };

struct StaticOrder {
    int nM, nN, nwg, G, c;
    __host__ __device__ void init(int M, int N, int G_, int c_) { nM = M / BM; nN = N / BM; nwg = nM * nN; G = G_; c = c_; }
    __host__ __device__ bool next(int i, Unit& u) const {
        const long L = (long)i * G + c; if (L >= nwg) return false;
        int wgid = (int)L; { const int q = nwg / NXCD, r = nwg % NXCD, xcd = wgid % NXCD, off = wgid / NXCD; wgid = (xcd < r ? xcd * (q + 1) : r * (q + 1) + (xcd - r) * q) + off; }
        const int nig = WGM * nN, gid = wgid / nig, fm = gid * WGM, gsz = (nM - fm) < WGM ? (nM - fm) : WGM;
        u.pm = fm + ((wgid % nig) % gsz); u.pn = (wgid % nig) / gsz; u.idx = i; return true;
    }
    __device__ __forceinline__ void a_ready(const Unit&) const {}
    __device__ __forceinline__ void done(const Unit&) const {}
};

struct EpiSwiGLU {
    static constexpr bool PERM = true, AFTER_DRAIN = false;
    bf16_t* H; const LAS float* rstab;
    __device__ __forceinline__ void operator()(const f32x4 (&acc)[2][2][4][2], const Unit& u, int wr, int wc, int fr, int fq) const {
        const int col0 = u.pn * 128 + wc * 32 + 8 * fq;
#pragma unroll
        for (int ai = 0; ai < 2; ++ai)
#pragma unroll
            for (int m = 0; m < 4; ++m) {
                const int rin = ai * HALF + wr * 64 + m * 16 + fr; const float rs = rstab[u.idx * 256 + rin];
                float h[8];
#pragma unroll
                for (int n = 0; n < 2; ++n)
#pragma unroll
                    for (int j = 0; j < 4; ++j) h[n * 4 + j] = silu_f(acc[ai][0][m][n][j] * rs) * (acc[ai][1][m][n][j] * rs);
                u32x4 w; w.x = cvt_pk_bf16(h[0], h[1]); w.y = cvt_pk_bf16(h[2], h[3]); w.z = cvt_pk_bf16(h[4], h[5]); w.w = cvt_pk_bf16(h[6], h[7]);
                *(u32x4*)(H + (size_t)(u.pm * BM + rin) * DFF + col0) = w;
            }
    }
};
template <int MODE> struct EpiResid {
    static constexpr bool PERM = true, AFTER_DRAIN = false;
    const float* xold; float* xnew; bf16_t* xb; float* ssq; float alpha;
    __device__ __forceinline__ void operator()(const f32x4 (&acc)[2][2][4][2], const Unit& u, int wr, int wc, int fr, int fq) const {
        const int col0 = u.pn * BM + wc * 32 + 8 * fq;
#pragma unroll
        for (int ai = 0; ai < 2; ++ai)
#pragma unroll
            for (int m = 0; m < 4; ++m) {
                const int row = u.pm * BM + ai * HALF + wr * 64 + m * 16 + fr; const size_t off = (size_t)row * DM + col0; float ss = 0.f;
#pragma unroll
                for (int bj = 0; bj < 2; ++bj) {
                    f32x4 o0, o1;
                    if (MODE == 0) { o0 = *(const f32x4*)(xold + off + bj * HALF); o1 = *(const f32x4*)(xold + off + bj * HALF + 4); }
                    else { const u32x4 w = *(const u32x4*)(xb + off + bj * HALF);
                        o0 = (f32x4){__uint_as_float(w.x << 16), __uint_as_float(w.x & 0xffff0000u), __uint_as_float(w.y << 16), __uint_as_float(w.y & 0xffff0000u)};
                        o1 = (f32x4){__uint_as_float(w.z << 16), __uint_as_float(w.z & 0xffff0000u), __uint_as_float(w.w << 16), __uint_as_float(w.w & 0xffff0000u)}; }
                    const f32x4 n0 = o0 + acc[ai][bj][m][0] * alpha, n1 = o1 + acc[ai][bj][m][1] * alpha;
                    ss += (n0[0] * n0[0] + n0[1] * n0[1]) + (n0[2] * n0[2] + n0[3] * n0[3]) + (n1[0] * n1[0] + n1[1] * n1[1]) + (n1[2] * n1[2] + n1[3] * n1[3]);
                    if (MODE == 2) { *(f32x4*)(xnew + off + bj * HALF) = n0; *(f32x4*)(xnew + off + bj * HALF + 4) = n1; }
                    else { u32x4 w; w.x = cvt_pk_bf16(n0[0], n0[1]); w.y = cvt_pk_bf16(n0[2], n0[3]); w.z = cvt_pk_bf16(n1[0], n1[1]); w.w = cvt_pk_bf16(n1[2], n1[3]);
                        *(u32x4*)(xb + off + bj * HALF) = w; }
                }
                ss += __shfl_xor(ss, 16); ss += __shfl_xor(ss, 32);
                if (fq == 0) ssq[(size_t)row * 16 + u.pn * 4 + wc] = ss;
                asm volatile("" ::: "memory");
            }
    }
};
struct EpiWin {
    static constexpr bool PERM = true, AFTER_DRAIN = false;
    bf16_t *Qb, *Kb, *Vb, *Ub, *GVb; float* out; const float* gnorm; const LAS float* rstab; LAS float* gx;
    __device__ __forceinline__ void operator()(const f32x4 (&acc)[2][2][4][2], const Unit& u, int wr, int wc, int fr, int fq) const {
        const int kind = u.pn >> 1;
        const int cbase = (u.pn & 1) * 256 + wc * 32 + 8 * fq;
        if (kind == 4) {
#pragma unroll
            for (int ai = 0; ai < 2; ++ai)
#pragma unroll
                for (int m = 0; m < 4; ++m) {
                    const int rin = ai * HALF + wr * 64 + m * 16 + fr; const float rs = rstab[u.idx * 256 + rin];
#pragma unroll
                    for (int bj = 0; bj < 2; ++bj) {
                        float ss = 0.f;
#pragma unroll
                        for (int n = 0; n < 2; ++n)
#pragma unroll
                            for (int j = 0; j < 4; ++j) { const float g = gelu_f(acc[ai][bj][m][n][j] * rs); ss += g * g; }
                        ss += __shfl_xor(ss, 16); ss += __shfl_xor(ss, 32);
                        if (fq == 0) gx[(rin * 2 + bj) * 4 + wc] = ss;
                    }
                }
            asm volatile("s_waitcnt lgkmcnt(0)\n\ts_barrier" ::: "memory");
        }
#pragma unroll
        for (int ai = 0; ai < 2; ++ai)
#pragma unroll
            for (int m = 0; m < 4; ++m) {
                const int rin = ai * HALF + wr * 64 + m * 16 + fr; const int row = u.pm * BM + rin; const float rs = rstab[u.idx * 256 + rin];
#pragma unroll
                for (int bj = 0; bj < 2; ++bj) {
                    const int col = cbase + bj * HALF;
                    f32x4 v0 = acc[ai][bj][m][0] * rs, v1 = acc[ai][bj][m][1] * rs;
                    bf16_t* dst;
                    if (kind == 0) { v0 = v0 * C2; v1 = v1 * C2; dst = Qb; }
                    else if (kind == 1 || kind == 2) {
                        dst = (kind == 1) ? Kb : Vb;
                        float* o = out + ((row < MP) ? ((kind == 1 ? O_KP : O_VP) + (size_t)row * AW) : ((kind == 1 ? O_KS : O_VS) + (size_t)(row - MP) * AW)) + col;
                        *(f32x4*)o = v0; *(f32x4*)(o + 4) = v1;
                    } else if (kind == 3) {
#pragma unroll
                        for (int j = 0; j < 4; ++j) { v0[j] = gelu_f(v0[j]); v1[j] = gelu_f(v1[j]); }
                        dst = Ub;
                    } else {
                        const LAS f32x4* gp = (const LAS f32x4*)(gx + (rin * 2 + bj) * 4); const f32x4 p = *gp;
                        const float rg = __builtin_amdgcn_rsqf(((p[0] + p[1]) + (p[2] + p[3])) * (1.f / 128.f) + EPS);
                        const f32x4 g0 = *(const f32x4*)(gnorm + col), g1 = *(const f32x4*)(gnorm + col + 4);
#pragma unroll
                        for (int j = 0; j < 4; ++j) { v0[j] = gelu_f(v0[j]) * rg * g0[j]; v1[j] = gelu_f(v1[j]) * rg * g1[j]; }
                        dst = GVb;
                        if (row >= MP) { float* o = out + O_GS + (size_t)(row - MP) * AW + col; *(f32x4*)o = v0; *(f32x4*)(o + 4) = v1; }
                    }
                    u32x4 w; w.x = cvt_pk_bf16(v0[0], v0[1]); w.y = cvt_pk_bf16(v0[2], v0[3]); w.z = cvt_pk_bf16(v1[0], v1[1]); w.w = cvt_pk_bf16(v1[2], v1[3]);
                    *(u32x4*)(dst + (size_t)row * AW + col) = w;
                }
                asm volatile("" ::: "memory");
            }
    }
};

template <class Epi, class Sched, bool ALIGN_EPI = false, bool SP2 = true>
__device__ __forceinline__ void gemm_phase(LAS unsigned char* lds, const Gemm g, const Sched& S, const Epi& E) {
    const int tid = threadIdx.x, wid = __builtin_amdgcn_readfirstlane(tid >> 6), lane = tid & 63, wr = wid >> 2, wc = wid & 3, fr = lane & 15, fq = lane >> 4;
    const int K = g.K, nt = K / BK;
    unsigned voffA[2], voffB[2];
#pragma unroll
    for (int i = 0; i < 2; ++i) { int R, C; stage_rc(tid * 16 + i * 8192, R, C); const int Rb = Epi::PERM ? ((R & ~31) + perm32(R & 31)) : R;
        voffA[i] = (unsigned)(R * K + C) * 2u; voffB[i] = (unsigned)(Rb * K + C) * 2u; }
    const size_t kstep = (size_t)(BK * 2);
    const size_t hstep = (size_t)HALF * K * 2;
    const size_t tstep = 2 * hstep;
    const unsigned ldsw = (unsigned)wid * 1024u;
    const int aoff = lds_byte(wr * 64 + fr, fq * 8), boff = lds_byte(wc * 32 + fr, fq * 8);
#define PG8_SA(b, h) (((b) * 2 + (h)) * HTB)
#define PG8_SB(b, h) ((4 + (b) * 2 + (h)) * HTB)
#define PG8_STAGE(bufoff, gbase, voff) do { _Pragma("unroll") for (int _i = 0; _i < 2; ++_i) \
        __builtin_amdgcn_global_load_lds((const unsigned*)((const char*)(gbase) + (voff)[_i]), (LAS unsigned*)(lds + (bufoff) + ldsw + _i * 8192), 16, 0, 0); } while (0)
#define PG8_LDA(dst, b, h) do { _Pragma("unroll") for (int m = 0; m < 4; ++m) _Pragma("unroll") for (int k = 0; k < 2; ++k) dst[m][k] = *(const LAS bf16x8*)(lds + PG8_SA(b, h) + aoff + m * 2048 + k * 1024); } while (0)
#define PG8_LDB(dst, b, h) do { _Pragma("unroll") for (int n = 0; n < 2; ++n) _Pragma("unroll") for (int k = 0; k < 2; ++k) dst[n][k] = *(const LAS bf16x8*)(lds + PG8_SB(b, h) + boff + n * 2048 + k * 1024); } while (0)
#define PG8_MMA(ai, bj, At, Bt) do { __builtin_amdgcn_s_setprio(1); _Pragma("unroll") for (int m = 0; m < 4; ++m) _Pragma("unroll") for (int n = 0; n < 2; ++n) _Pragma("unroll") for (int k = 0; k < 2; ++k) \
        acc[ai][bj][m][n] = __builtin_amdgcn_mfma_f32_16x16x32_bf16(Bt[n][k], At[m][k], acc[ai][bj][m][n], 0, 0, 0); __builtin_amdgcn_s_setprio(0); } while (0)
#define PG8_WAIT_V(n) asm volatile("s_waitcnt vmcnt(" #n ")" ::: "memory")
#define PG8_WAIT_L(n) asm volatile("s_waitcnt lgkmcnt(" #n ")" ::: "memory")
#define PG8_BAR __builtin_amdgcn_s_barrier()
#define PG8_SCHED __builtin_amdgcn_sched_barrier(0)
    Unit cur, nxt; int ui = 0;
    if (!S.next(0, cur)) return;
    f32x4 acc[2][2][4][2];
#pragma unroll
    for (int a = 0; a < 2; ++a)
#pragma unroll
        for (int b = 0; b < 2; ++b)
#pragma unroll
            for (int m = 0; m < 4; ++m)
#pragma unroll
                for (int n = 0; n < 2; ++n) acc[a][b][m][n] = (f32x4){0.f, 0.f, 0.f, 0.f};
    bf16x8 At[4][2], B0[2][2], B1[2][2];
    const char* cA = (const char*)g.A + (size_t)cur.pm * tstep; const char* cB = (const char*)g.Bt + (size_t)cur.pn * tstep;
    S.a_ready(cur);
    PG8_STAGE(PG8_SB(0, 0), cB, voffB); PG8_STAGE(PG8_SB(0, 1), cB + hstep, voffB); PG8_STAGE(PG8_SA(0, 0), cA, voffA); PG8_STAGE(PG8_SA(0, 1), cA + hstep, voffA);
    if (wr == 1) PG8_BAR;
    PG8_WAIT_V(2); PG8_BAR;
    PG8_STAGE(PG8_SB(1, 0), cB + kstep, voffB); PG8_STAGE(PG8_SA(1, 0), cA + kstep, voffA); PG8_STAGE(PG8_SB(1, 1), cB + hstep + kstep, voffB);
    PG8_WAIT_V(6); PG8_BAR;
    for (;;) {
        const bool has_next = S.next(ui + 1, nxt);
        const char* nA = has_next ? (const char*)g.A + (size_t)nxt.pm * tstep : cA; const char* nB = has_next ? (const char*)g.Bt + (size_t)nxt.pn * tstep : cB;
        for (int t = 0; t < nt; t += 2) {
            const bool last = (t == nt - 2);
            const char* a1 = cA + (size_t)(t + 1) * kstep;
            const char* a2 = last ? nA : cA + (size_t)(t + 2) * kstep; const char* b2 = last ? nB : cB + (size_t)(t + 2) * kstep;
            const char* a3 = a2 + kstep; const char* b3 = b2 + kstep;
            if (last && has_next) S.a_ready(nxt);
            PG8_LDB(B0, 0, 0); PG8_LDB(B1, 0, 1); PG8_SCHED; PG8_LDA(At, 0, 0); PG8_STAGE(PG8_SA(1, 1), a1 + hstep, voffA);
            PG8_WAIT_V(8); PG8_WAIT_L(0); PG8_BAR; PG8_MMA(0, 0, At, B0); PG8_MMA(0, 1, At, B1); PG8_BAR; PG8_SCHED;
            PG8_LDA(At, 0, 1); PG8_STAGE(PG8_SB(0, 0), b2, voffB); PG8_STAGE(PG8_SB(0, 1), b2 + hstep, voffB); PG8_STAGE(PG8_SA(0, 0), a2, voffA);
            PG8_WAIT_V(8); PG8_WAIT_L(0); PG8_BAR; PG8_MMA(1, 0, At, B0); PG8_MMA(1, 1, At, B1); PG8_BAR; PG8_SCHED;
            PG8_LDB(B0, 1, 0); PG8_LDB(B1, 1, 1); PG8_SCHED; PG8_LDA(At, 1, 0); PG8_STAGE(PG8_SA(0, 1), a2 + hstep, voffA);
            PG8_WAIT_V(8); PG8_WAIT_L(0); PG8_BAR; PG8_MMA(0, 0, At, B0); PG8_MMA(0, 1, At, B1); PG8_BAR; PG8_SCHED;
            PG8_LDA(At, 1, 1); PG8_STAGE(PG8_SB(1, 0), b3, voffB); PG8_STAGE(PG8_SB(1, 1), b3 + hstep, voffB); PG8_STAGE(PG8_SA(1, 0), a3, voffA);
            PG8_WAIT_V(8); PG8_WAIT_L(0); PG8_BAR; PG8_MMA(1, 0, At, B0); PG8_MMA(1, 1, At, B1); PG8_BAR; PG8_SCHED;
        }
        if constexpr (ALIGN_EPI) { if (wr == 0) PG8_BAR; }
        E(acc, cur, wr, wc, fr, fq); S.done(cur);
        if (!has_next) break;
#pragma unroll
        for (int a = 0; a < 2; ++a)
#pragma unroll
            for (int b = 0; b < 2; ++b)
#pragma unroll
                for (int m = 0; m < 4; ++m)
#pragma unroll
                    for (int n = 0; n < 2; ++n) acc[a][b][m][n] = (f32x4){0.f, 0.f, 0.f, 0.f};
        cur = nxt; cA = nA; cB = nB; ++ui;
        if constexpr (ALIGN_EPI) { if (wr == 1) PG8_BAR; }
    }
    PG8_WAIT_V(0);
    if constexpr (!ALIGN_EPI) { if (wr == 0) PG8_BAR; }
    PG8_BAR;
#undef PG8_SA
#undef PG8_SB
#undef PG8_STAGE
#undef PG8_LDA
#undef PG8_LDB
#undef PG8_MMA
#undef PG8_WAIT_V
#undef PG8_WAIT_L
#undef PG8_BAR
#undef PG8_SCHED
}
}

#define XB_TMO      128
#define XB_XCNT(j)  (256  + 64 * (j))
#define XB_XSUB(j)  (1280 + 64 * (j))
#define XB_XGEN(j)  (2304 + 64 * (j))
#define XB_TOP      3328
#define XB_TOPGEN   3392
#define XCD_BAR_WORDS 3456
#define XB_SPIN_CAP (1u << 18)
__device__ __forceinline__ unsigned xb_ld(unsigned* p)              { return __hip_atomic_load(p, __ATOMIC_RELAXED, __HIP_MEMORY_SCOPE_AGENT); }
__device__ __forceinline__ unsigned xb_add(unsigned* p, unsigned v) { return __hip_atomic_fetch_add(p, v, __ATOMIC_RELAXED, __HIP_MEMORY_SCOPE_AGENT); }
__device__ __forceinline__ unsigned xb_xcc_id() { return (unsigned)__builtin_amdgcn_s_getreg((3 << 11) | 20) & 0xFu; }
#define XB_SPIN(cond, bar) do { unsigned _sp = 0; while (cond) { __builtin_amdgcn_s_sleep(1); \
    if ((++_sp & 255u) == 0u) { if (xb_ld(&(bar)[XB_TMO])) break; if (_sp > XB_SPIN_CAP) { atomicAdd(&(bar)[XB_TMO], 1u); break; } } } } while (0)
struct XcdBarrier { unsigned* bar; unsigned x; volatile LAS unsigned* st; };
__device__ __forceinline__ XcdBarrier xcd_barrier_post(unsigned* bar, volatile LAS unsigned* st) {
    XcdBarrier b; b.bar = bar; b.x = xb_xcc_id(); b.st = st;
    if (threadIdx.x == 0) (void)xb_add(&bar[XB_XCNT(b.x)], 1u);
    return b;
}
__device__ __forceinline__ void xcd_barrier_complete(unsigned* bar, unsigned x, unsigned& nloc, unsigned& nx) {
    const unsigned G = gridDim.x * gridDim.y * gridDim.z;
    unsigned sum, cnt, mine, sp = 0u;
    for (;;) {
        sum = 0u; cnt = 0u; mine = 0u;
#pragma unroll
        for (unsigned j = 0; j < 16; ++j) { const unsigned c = xb_ld(&bar[XB_XCNT(j)]); sum += c; cnt += (c > 0u) ? 1u : 0u; mine = (j == x) ? c : mine; }
        if (sum == G) break;
        __builtin_amdgcn_s_sleep(1);
        if ((++sp & 255u) == 0u) { if (xb_ld(&bar[XB_TMO])) break; if (sp > XB_SPIN_CAP) { atomicAdd(&bar[XB_TMO], 1u); break; } }
    }
    nloc = mine > 0u ? mine : 1u; nx = cnt > 0u ? cnt : 1u;
}
__device__ __forceinline__ void xcd_barrier(const XcdBarrier& b) {
    asm volatile("s_waitcnt vmcnt(0)" ::: "memory");
    __syncthreads();
    if (threadIdx.x == 0) {
        unsigned* bar = b.bar;
        __builtin_amdgcn_s_waitcnt(0);
        unsigned nloc = b.st[0], nx = b.st[1];
        if (nloc == 0u) { xcd_barrier_complete(bar, b.x, nloc, nx); b.st[0] = nloc; b.st[1] = nx; }
        const unsigned old = xb_add(&bar[XB_XSUB(b.x)], 1u);
        const unsigned gen = old / nloc;
        if (old + 1u == (gen + 1u) * nloc) {
            __builtin_amdgcn_fence(__ATOMIC_RELEASE, "agent");
            asm volatile("s_waitcnt vmcnt(0)" ::: "memory");
            const unsigned og = xb_add(&bar[XB_TOP], 1u);
            const unsigned tg = og / nx;
            if (og + 1u == (tg + 1u) * nx) xb_add(&bar[XB_TOPGEN], 1u);
            else XB_SPIN(xb_ld(&bar[XB_TOPGEN]) == tg, bar);
            __builtin_amdgcn_fence(__ATOMIC_ACQUIRE, "agent");
            xb_add(&bar[XB_XGEN(b.x)], 1u);
            asm volatile("s_waitcnt vmcnt(0)" ::: "memory");
        } else {
            XB_SPIN(xb_ld(&bar[XB_XGEN(b.x)]) == gen, bar);
            __builtin_amdgcn_fence(__ATOMIC_ACQUIRE, "agent");
            asm volatile("s_waitcnt vmcnt(0)" ::: "memory");
        }
    }
    __syncthreads();
}

struct Args { const float* in[24]; const int* page_table; float* out; unsigned char* ws; int ph_lo, ph_hi, li, pad; };
enum { I_XP = 0, I_XS, I_CK, I_CV, I_PT, I_REL, I_NF1, I_WGU1, I_WD1, I_NM, I_WIN, I_LQ1, I_LK1, I_LQ2, I_LK2, I_SUBLN, I_GNORM, I_WS, I_BS, I_WOUT, I_NF2, I_WGU2, I_WD2, I_NFIN };

struct Frame {
    LAS unsigned char* lds; volatile LAS unsigned* MISC; unsigned* ctl;
    int tid, lane, wave, vcu, G;
    unsigned char* ws; float* out;
};

__device__ __forceinline__ void p0_transpose_item(const float* W, int K, int N, bf16_t* WT, int drow0, int k0, int n0, const float* gain, LAS float* scr, int lane) {
    const int rr = lane >> 3, c4 = 4 * (lane & 7);
    f32x4 v[8]; float g[8];
#pragma unroll
    for (int i = 0; i < 8; ++i) { const int kk = 8 * i + rr; v[i] = *(const f32x4*)(W + (size_t)(k0 + kk) * N + n0 + c4); g[i] = gain ? gain[k0 + kk] : 1.f; }
#pragma unroll
    for (int i = 0; i < 8; ++i) { const int kk = 8 * i + rr;
#pragma unroll
        for (int j = 0; j < 4; ++j) scr[kk * 33 + c4 + j] = v[i][j] * g[i]; }
    LDS_WAIT(); asm volatile("" ::: "memory");
    const int c = lane & 7;
#pragma unroll
    for (int j = 0; j < 4; ++j) { const int n = (lane >> 3) + 8 * j; const LAS float* s = scr + (8 * c) * 33 + n;
        u32x4 o; o.x = cvt_pk_bf16(s[0 * 33], s[1 * 33]); o.y = cvt_pk_bf16(s[2 * 33], s[3 * 33]); o.z = cvt_pk_bf16(s[4 * 33], s[5 * 33]); o.w = cvt_pk_bf16(s[6 * 33], s[7 * 33]);
        *(u32x4*)(WT + (size_t)(drow0 + n) * K + k0 + 8 * c) = o; }
    LDS_WAIT(); asm volatile("" ::: "memory");
}
__device__ __forceinline__ int gu_drow(int n0) { return (n0 < DFF) ? ((n0 >> 7) * 256 + (n0 & 127)) : (((n0 - DFF) >> 7) * 256 + 128 + ((n0 - DFF) & 127)); }

__device__ __forceinline__ void p0_prologue(Frame& F, const Args& a) {
    LAS float* scr = (LAS float*)(F.lds + F.wave * 16384);
    const int gw = F.vcu * NWAVES + F.wave, NGW = F.G * NWAVES;
    constexpr int I_GU = (DM / 64) * (NGU / 32), I_DN = (DFF / 64) * (DM / 32), I_IN = (DM / 64) * (NIN / 32), I_OUT = (DM / 64) * (DM / 32);
    constexpr int NITEMS = 2 * I_GU + 2 * I_DN + I_IN + I_OUT;
    for (int it = gw; it < NITEMS; it += NGW) {
        int r = it;
        if (r < I_GU) { const int nb = NGU / 32, k0 = 64 * (r / nb), n0 = 32 * (r % nb); p0_transpose_item(a.in[I_WGU1], DM, NGU, (bf16_t*)(F.ws + WS_WGU1), gu_drow(n0), k0, n0, a.in[I_NF1], scr, F.lane); continue; } r -= I_GU;
        if (r < I_GU) { const int nb = NGU / 32, k0 = 64 * (r / nb), n0 = 32 * (r % nb); p0_transpose_item(a.in[I_WGU2], DM, NGU, (bf16_t*)(F.ws + WS_WGU2), gu_drow(n0), k0, n0, a.in[I_NF2], scr, F.lane); continue; } r -= I_GU;
        if (r < I_DN) { const int nb = DM / 32, k0 = 64 * (r / nb), n0 = 32 * (r % nb); p0_transpose_item(a.in[I_WD1], DFF, DM, (bf16_t*)(F.ws + WS_WD1), n0, k0, n0, nullptr, scr, F.lane); continue; } r -= I_DN;
        if (r < I_DN) { const int nb = DM / 32, k0 = 64 * (r / nb), n0 = 32 * (r % nb); p0_transpose_item(a.in[I_WD2], DFF, DM, (bf16_t*)(F.ws + WS_WD2), n0, k0, n0, nullptr, scr, F.lane); continue; } r -= I_DN;
        if (r < I_IN) { const int nb = NIN / 32, k0 = 64 * (r / nb), n0 = 32 * (r % nb); p0_transpose_item(a.in[I_WIN], DM, NIN, (bf16_t*)(F.ws + WS_WIN), n0, k0, n0, a.in[I_NM], scr, F.lane); continue; } r -= I_IN;
        { const int nb = DM / 32, k0 = 64 * (r / nb), n0 = 32 * (r % nb); p0_transpose_item(a.in[I_WOUT], DM, DM, (bf16_t*)(F.ws + WS_WOUT), n0, k0, n0, nullptr, scr, F.lane); }
    }
    bf16_t* XB = (bf16_t*)(F.ws + WS_XB); float* SSQ = (float*)(F.ws + WS_SSQ);
    for (int m0 = gw; m0 < MT; m0 += 2 * NGW) {
        const int m1 = (m0 + NGW < MT) ? m0 + NGW : m0;
        const float* xr0 = (m0 < MP) ? a.in[I_XP] + (size_t)m0 * DM : a.in[I_XS] + (size_t)(m0 - MP) * DM;
        const float* xr1 = (m1 < MP) ? a.in[I_XP] + (size_t)m1 * DM : a.in[I_XS] + (size_t)(m1 - MP) * DM;
        f32x4 v0[4], v1[4]; float s0 = 0.f, s1 = 0.f;
#pragma unroll
        for (int j = 0; j < 4; ++j) { v0[j] = ((const f32x4*)xr0)[F.lane + 64 * j]; v1[j] = ((const f32x4*)xr1)[F.lane + 64 * j]; }
#pragma unroll
        for (int j = 0; j < 4; ++j) { s0 += (v0[j].x * v0[j].x + v0[j].y * v0[j].y) + (v0[j].z * v0[j].z + v0[j].w * v0[j].w); s1 += (v1[j].x * v1[j].x + v1[j].y * v1[j].y) + (v1[j].z * v1[j].z + v1[j].w * v1[j].w); }
#pragma unroll
        for (int o = 1; o < 64; o <<= 1) { s0 += __shfl_xor(s0, o); s1 += __shfl_xor(s1, o); }
        u32x2* o0 = (u32x2*)(XB + (size_t)m0 * DM) + F.lane; u32x2* o1 = (u32x2*)(XB + (size_t)m1 * DM) + F.lane;
#pragma unroll
        for (int j = 0; j < 4; ++j) { u32x2 w; w.x = cvt_pk_bf16(v0[j].x, v0[j].y); w.y = cvt_pk_bf16(v0[j].z, v0[j].w); o0[64 * j] = w;
                                      u32x2 w1; w1.x = cvt_pk_bf16(v1[j].x, v1[j].y); w1.y = cvt_pk_bf16(v1[j].z, v1[j].w); o1[64 * j] = w1; }
        if (F.lane < 16) { SSQ[(size_t)m0 * 16 + F.lane] = (F.lane == 0) ? s0 : 0.f; SSQ[(size_t)m1 * 16 + F.lane] = (F.lane == 0) ? s1 : 0.f; }
    }
    const int gt = F.vcu * 512 + F.tid, NGT = F.G * 512;
    bf16_t* WT = (bf16_t*)(F.ws + WS_WTRIL);
    for (int e = gt; e < 4 * 128 * 128; e += NGT) { const int i = (e >> 7) & 127, j = e & 127; const float w = (j <= i) ? a.in[I_WS][e] : 0.f; WT[e] = (bf16_t)(cvt_pk_bf16(w, 0.f) & 0xffffu); }
    float* BT = (float*)(F.ws + WS_BTAB);
    for (int e = gt; e < 8 * 128; e += NGT) { const int m = e >> 7, d = e & 127; int bk;
        if (d < 16) bk = d; else { bk = 16 + (int)(__logf((float)d * (1.f / 16.f)) / 2.0794415416798357f * 16.f); if (bk > 31) bk = 31; }
        BT[e] = a.in[I_REL][bk * 8 + m] * LOG2E; }
}

template <class Sched> __device__ __forceinline__ void rstab_fill(Frame& F, const Sched& S) {
    LAS float* rstab = (LAS float*)(F.lds + RSTAB_OFF); const float* SSQ = (const float*)(F.ws + WS_SSQ);
    pg8::Unit u;
    for (int i = 0; i < 6 && S.next(i, u); ++i) {
        if ((i & 1) == (F.tid >> 8)) { const int r = F.tid & 255; const f32x4* p = (const f32x4*)(SSQ + (size_t)(u.pm * 256 + r) * 16);
            const f32x4 a = p[0], b = p[1], c = p[2], d = p[3]; const f32x4 s = (a + b) + (c + d);
            rstab[i * 256 + r] = __builtin_amdgcn_rsqf(((s[0] + s[1]) + (s[2] + s[3])) * (1.f / DM) + EPS); }
    }
    __syncthreads();
}

template <int MODE> __device__ __forceinline__ void mini_gemm_resid(Frame& F, const bf16_t* A, const bf16_t* Bt, int K, const float* xold, int xoff, float* xnew, bf16_t* xb, float alpha) {
    LAS float* red = (LAS float*)F.lds;
    LAS float* ssr = (LAS float*)(F.lds + 32768);
    float* SSQ = (float*)(F.ws + WS_SSQ);
    const int fr = F.lane & 15, fq = F.lane >> 4, kw = K / 8;
    for (int t = F.vcu; t < 256; t += F.G) {
        const int rb = t >> 4, cb = t & 15;
        f32x4 acc[4];
#pragma unroll
        for (int n = 0; n < 4; ++n) acc[n] = (f32x4){0.f, 0.f, 0.f, 0.f};
        const bf16_t* ap = A + (size_t)(MP + 16 * rb + fr) * K + F.wave * kw + 8 * fq;
        const bf16_t* bp = Bt + (size_t)(64 * cb + fr) * K + F.wave * kw + 8 * fq;
        for (int s = 0; s < kw; s += 32) {
            const bf16x8 af = *(const bf16x8*)(ap + s);
#pragma unroll
            for (int n = 0; n < 4; ++n) { const bf16x8 bf = *(const bf16x8*)(bp + (size_t)16 * n * K + s); acc[n] = __builtin_amdgcn_mfma_f32_16x16x32_bf16(bf, af, acc[n], 0, 0, 0); }
        }
#pragma unroll
        for (int n = 0; n < 4; ++n) *(LAS f32x4*)(red + (F.wave * 64 + F.lane) * 16 + n * 4) = acc[n];
        __syncthreads();
        const int e = 2 * F.wave;
        f32x2 sum = (f32x2){0.f, 0.f};
#pragma unroll
        for (int w = 0; w < 8; ++w) { const f32x2 p = *(const LAS f32x2*)(red + (w * 64 + F.lane) * 16 + e); sum += p; }
        const int row = MP + 16 * rb + fr, col = 64 * cb + 16 * (e >> 2) + 4 * fq + (e & 3);
        const size_t off = (size_t)row * DM + col;
        f32x2 xo;
        if (MODE == 0) xo = *(const f32x2*)(xold + off - (size_t)xoff * DM);
        else { const unsigned w = *(const unsigned*)(xb + off); xo = (f32x2){__uint_as_float(w << 16), __uint_as_float(w & 0xffff0000u)}; }
        const f32x2 xn = xo + sum * alpha;
        if (MODE == 2) *(f32x2*)(xnew + off) = xn; else *(unsigned*)(xb + off) = cvt_pk_bf16(xn[0], xn[1]);
        float ss = xn[0] * xn[0] + xn[1] * xn[1]; ss += __shfl_xor(ss, 16); ss += __shfl_xor(ss, 32);
        if (fq == 0) ssr[F.wave * 16 + fr] = ss;
        __syncthreads();
        if (F.tid < 16) { float s = 0.f;
#pragma unroll
            for (int w = 0; w < 8; ++w) s += ssr[w * 16 + F.tid];
            SSQ[(size_t)(MP + 16 * rb + F.tid) * 16 + cb] = s; }
        __syncthreads();
    }
}

namespace att {
typedef LAS const char* lds_cptr;
typedef short v4i16_t __attribute__((ext_vector_type(4)));
__device__ __forceinline__ int crow(int r, int hi) { return (r & 3) + 8 * (r >> 2) + 4 * hi; }
__device__ __forceinline__ void glds16(const void* gsrc, unsigned lds_dst) { unsigned keep;
    asm volatile("s_mov_b32 %0, m0\n\ts_mov_b32 m0, %2\n\ts_nop 0\n\tglobal_load_lds_dwordx4 %1, off\n\ts_mov_b32 m0, %0" : "=&s"(keep) : "v"(gsrc), "s"(lds_dst) : "memory"); }
__device__ __forceinline__ s16x4 vtr(lds_cptr p) { return __builtin_bit_cast(s16x4, __builtin_amdgcn_ds_read_tr16_b64_v4i16((LAS v4i16_t*)p)); }
#define MX3(a, b, c) __builtin_fmaxf(__builtin_fmaxf((a), (b)), (c))
__device__ __forceinline__ float rowmax32(const f32x16& p0, const f32x16& p1) {
    float a = MX3(p0[0], p0[1], p1[0]), b = MX3(p0[2], p0[3], p1[1]); a = MX3(a, p1[2], p1[3]);
#pragma unroll
    for (int r = 4; r < 16; r += 4) { a = MX3(a, p0[r], p0[r + 1]); b = MX3(b, p0[r + 2], p0[r + 3]); a = MX3(a, p1[r], p1[r + 1]); b = MX3(b, p1[r + 2], p1[r + 3]); }
    const float m = __builtin_fmaxf(a, b);
    return __builtin_fmaxf(m, __shfl_xor(m, 32));
}
#define WAIT_BAR(N) asm volatile("s_waitcnt vmcnt(" #N ") lgkmcnt(0)\n\ts_barrier" ::: "memory")
constexpr int BUFB = 32768, NBUF = 3;
constexpr int L_WSF = 98304, L_LINV = 98304 + 2048, L_BTAB = 98304 + 4096, L_MISC = 98304 + 8192;
constexpr float THR = 6.0f;

__device__ __forceinline__ void attn_unit(int b, int h, int qb, const bf16_t* Qb, const bf16_t* Kb, const bf16_t* Vb, bf16_t* MIX, const float* subln, float lam, LAS unsigned char* lds) {
    const int tid = threadIdx.x, lane = tid & 63, r32 = lane & 31, hi = lane >> 5; const int wid = __builtin_amdgcn_readfirstlane(tid >> 6);
    const int mi = wid >> 2, sub = wid & 3;
    const int q0 = qb * 128, qw = q0 + 32 * sub, NT = (q0 + 128) / 64;
    const size_t rowbase = (size_t)b * SEQ;
    const unsigned lds0 = (unsigned)(uintptr_t)lds;
    const bf16_t* ksrc0 = Kb + (rowbase + lane) * AW + (2 * h) * 64 + wid * 8;
    const bf16_t* ksrc1 = ksrc0 + 64;
    const bf16_t* vsrc0 = Vb + (rowbase + 16 * (wid & 3) + (lane >> 2)) * AW + h * 128 + (wid >> 2) * 32 + (lane & 3) * 8;
    const bf16_t* vsrc1 = vsrc0 + 64;
#define DMA_TILE(t, boff) do { const size_t go_ = (size_t)(t) * 64 * AW; const unsigned bo_ = lds0 + (boff) + wid * 1024; \
        glds16(ksrc0 + go_, (unsigned)__builtin_amdgcn_readfirstlane(bo_)); glds16(ksrc1 + go_, (unsigned)__builtin_amdgcn_readfirstlane(bo_ + 8192)); \
        glds16(vsrc0 + go_, (unsigned)__builtin_amdgcn_readfirstlane(bo_ + 16384)); glds16(vsrc1 + go_, (unsigned)__builtin_amdgcn_readfirstlane(bo_ + 16384 + 8192)); } while (0)
    DMA_TILE(0, 0); DMA_TILE(1, BUFB);
    bf16x8 qr[4];
    { const bf16_t* Qw = Qb + (rowbase + qw + r32) * AW + (2 * h + mi) * 64 + hi * 8;
#pragma unroll
      for (int d0 = 0; d0 < 4; ++d0) qr[d0] = *(const bf16x8*)(Qw + d0 * 16); }
    LAS float* wsf = (LAS float*)(lds + L_WSF) + wid * 64;
    const LAS float* bt = (const LAS float*)(lds + L_BTAB) + (2 * h + mi) * 128;
    const float b31 = bt[127];
    float mhat = -INFINITY, l_reg = 0.f;
    f32x16 o[4];
#pragma unroll
    for (int d = 0; d < 4; ++d) o[d] = f32x16{};
    const lds_cptr kp0 = (lds_cptr)lds + mi * 8192 + hi * 1024 + r32 * 16;
    const lds_cptr vp0 = (lds_cptr)lds + 16384 + ((lane >> 4) & 1) * 32 + (lane & 3) * 8 + (4 * hi + ((lane & 15) >> 2)) * 64;
    int sl = 0, sl2 = 2 * BUFB;
#pragma unroll 1
    for (int t = 0; t < NT; ++t) {
        if (t + 1 < NT) WAIT_BAR(4); else WAIT_BAR(0);
        if (t + 2 < NT) DMA_TILE(t + 2, sl2);
        const int k0 = 64 * t;
        if (k0 <= qw + 31) {
            f32x16 p0 = f32x16{}, p1 = f32x16{};
#pragma unroll
            for (int d0 = 0; d0 < 4; ++d0) {
                const bf16x8 k0f = *(const LAS bf16x8*)(kp0 + sl + d0 * 2048), k1f = *(const LAS bf16x8*)(kp0 + sl + d0 * 2048 + 512);
                p0 = __builtin_amdgcn_mfma_f32_32x32x16_bf16(k0f, qr[d0], p0, 0, 0, 0); p1 = __builtin_amdgcn_mfma_f32_32x32x16_bf16(k1f, qr[d0], p1, 0, 0, 0);
            }
            float cadd = b31;
            if (k0 + 63 > qw - 113) {
                cadd = 0.f; const int dq = qw + r32 - k0 - 4 * hi;
#pragma unroll
                for (int r = 0; r < 16; ++r) { const int d0_ = dq - ((r & 3) + 8 * (r >> 2)), d1_ = d0_ - 32;
                    p0[r] = (d0_ < 0) ? -INFINITY : p0[r] + bt[d0_ > 127 ? 127 : d0_];
                    p1[r] = (d1_ < 0) ? -INFINITY : p1[r] + bt[d1_ > 127 ? 127 : d1_]; }
            }
            const float rm = rowmax32(p0, p1) + cadd;
            if (__any(rm > mhat + THR)) {
                const float mnew = __builtin_fmaxf(mhat, rm); const float f = __builtin_amdgcn_exp2f(mhat - mnew); mhat = mnew; l_reg *= f;
                if (hi == 0) wsf[r32] = f;
                LDS_WAIT();
#pragma unroll
                for (int r = 0; r < 16; ++r) { const float fr_ = wsf[crow(r, hi)];
#pragma unroll
                    for (int d = 0; d < 4; ++d) o[d][r] *= fr_; }
            }
            const float nm = cadd - mhat; float sacc = 0.f;
#pragma unroll
            for (int r = 0; r < 16; ++r) { p0[r] = __builtin_amdgcn_exp2f(p0[r] + nm); p1[r] = __builtin_amdgcn_exp2f(p1[r] + nm); sacc += p0[r] + p1[r]; }
            l_reg += sacc;
            u32x4 pw[4];
#pragma unroll
            for (int j = 0; j < 4; ++j) { pw[0][j] = cvt_pk_bf16(p0[2 * j], p0[2 * j + 1]); pw[1][j] = cvt_pk_bf16(p0[8 + 2 * j], p0[8 + 2 * j + 1]);
                                          pw[2][j] = cvt_pk_bf16(p1[2 * j], p1[2 * j + 1]); pw[3][j] = cvt_pk_bf16(p1[8 + 2 * j], p1[8 + 2 * j + 1]); }
#pragma unroll
            for (int ks = 0; ks < 4; ++ks)
#pragma unroll
                for (int d = 0; d < 4; ++d) {
                    const s16x4 lo = vtr(vp0 + sl + d * 4096 + ks * 1024), hh = vtr(vp0 + sl + d * 4096 + ks * 1024 + 512);
                    const bf16x8 vf = (bf16x8){lo[0], lo[1], lo[2], lo[3], hh[0], hh[1], hh[2], hh[3]};
                    o[d] = __builtin_amdgcn_mfma_f32_32x32x16_bf16(__builtin_bit_cast(bf16x8, pw[ks]), vf, o[d], 0, 0, 0);
                }
        }
        sl = (sl == 2 * BUFB) ? 0 : sl + BUFB; sl2 = (sl2 == 2 * BUFB) ? 0 : sl2 + BUFB;
    }
    l_reg += __shfl_xor(l_reg, 32);
    WAIT_BAR(0);
    int hiF = hi, r32F = r32; asm volatile("" : "+v"(hiF), "+v"(r32F));
    LAS float* linv = (LAS float*)(lds + L_LINV);
    if (hiF == 0) linv[(mi * 4 + sub) * 32 + r32F] = l_reg;
    LAS float* stg = (LAS float*)lds + sub * 4096 + hiF * 512 + r32F;
    if (mi == 1) {
#pragma unroll
        for (int r = 0; r < 16; ++r)
#pragma unroll
            for (int d = 0; d < 4; ++d) stg[crow(r, 0) * 128 + d * 32] = o[d][r];
    }
    WAIT_BAR(0);
    if (mi == 0) {
        float sg[4];
#pragma unroll
        for (int d = 0; d < 4; ++d) sg[d] = subln[d * 32 + r32F] * (1.f - LAM_INIT);
        bf16_t* dst = MIX + (rowbase + qw + 4 * hiF) * DM + h * 128 + r32F;
        const LAS float* lv = linv + sub * 32 + 4 * hiF;
#pragma unroll
        for (int r = 0; r < 16; ++r) { const int row = crow(r, 0);
            const float a = __builtin_amdgcn_rcpf(lv[row]), bq = lam * __builtin_amdgcn_rcpf(lv[128 + row]);
            float v[4]; float ss = 0.f;
#pragma unroll
            for (int d = 0; d < 4; ++d) { v[d] = o[d][r] * a - bq * stg[row * 128 + d * 32]; ss += v[d] * v[d]; }
            ss += __shfl_xor(ss, 1); ss += __shfl_xor(ss, 2); ss += __shfl_xor(ss, 4); ss += __shfl_xor(ss, 8); ss += __shfl_xor(ss, 16);
            const float sc = __builtin_amdgcn_rsqf(ss * (1.f / 128.f) + EPS);
#pragma unroll
            for (int d = 0; d < 4; ++d) dst[(size_t)row * DM + d * 32] = (bf16_t)(cvt_pk_bf16(v[d] * sc * sg[d], 0.f) & 0xffffu);
        }
    }
    WAIT_BAR(0);
#undef DMA_TILE
}

__device__ __forceinline__ void spatial_unit(int c, int g, const bf16_t* GVb, const bf16_t* Ub, const bf16_t* WT, const float* bs, bf16_t* MIX, LAS unsigned char* lds) {
    const int tid = threadIdx.x, lane = tid & 63, r32 = lane & 31, hi = lane >> 5; const int wid = __builtin_amdgcn_readfirstlane(tid >> 6);
    const int ib = wid & 3, chh = wid >> 2;
    const unsigned lds0 = (unsigned)(uintptr_t)lds;
    const size_t row0 = (size_t)c * 128;
    VM_WAIT();
#pragma unroll
    for (int j = 0; j < 4; ++j) { const int p = wid + 8 * j, jt = p >> 4, db = (p >> 2) & 3, kg = p & 3;
        const bf16_t* src = GVb + (row0 + 64 * jt + 16 * kg + (lane >> 2)) * AW + g * 128 + db * 32 + (lane & 3) * 8;
        glds16(src, (unsigned)__builtin_amdgcn_readfirstlane(lds0 + jt * 16384 + (db * 4 + kg) * 1024)); }
    f32x16 o[2]; o[0] = f32x16{}; o[1] = f32x16{};
    const bf16_t* wrow = WT + ((size_t)g * 128 + 32 * ib + r32) * 128 + 4 * hi;
    WAIT_BAR(0);
    const lds_cptr vp0 = (lds_cptr)lds + ((lane >> 4) & 1) * 32 + (lane & 3) * 8 + (4 * hi + ((lane & 15) >> 2)) * 64;
#pragma unroll 1
    for (int ks = 0; ks < 2 * ib + 2; ++ks) {
        const u32x2 a0 = *(const u32x2*)(wrow + 16 * ks), a1 = *(const u32x2*)(wrow + 16 * ks + 8);
        const u32x4 aw = (u32x4){a0.x, a0.y, a1.x, a1.y};
        const int jt = ks >> 2, kk = ks & 3;
#pragma unroll
        for (int d = 0; d < 2; ++d) { const int db = 2 * chh + d;
            const s16x4 lo = vtr(vp0 + jt * 16384 + db * 4096 + kk * 1024), hh = vtr(vp0 + jt * 16384 + db * 4096 + kk * 1024 + 512);
            const bf16x8 vf = (bf16x8){lo[0], lo[1], lo[2], lo[3], hh[0], hh[1], hh[2], hh[3]};
            o[d] = __builtin_amdgcn_mfma_f32_32x32x16_bf16(__builtin_bit_cast(bf16x8, aw), vf, o[d], 0, 0, 0); }
    }
    int hiF = hi, r32F = r32; asm volatile("" : "+v"(hiF), "+v"(r32F));
#pragma unroll
    for (int r = 0; r < 16; ++r) { const int i = 32 * ib + crow(r, 0) + 4 * hiF; const float bi = bs[g * 128 + i];
#pragma unroll
        for (int d = 0; d < 2; ++d) { const int ch = g * 128 + (2 * chh + d) * 32 + r32F;
            const float uu = bf2f(Ub[(row0 + i) * AW + ch]);
            MIX[(row0 + i) * DM + 512 + ch] = (bf16_t)(cvt_pk_bf16(uu * (o[d][r] + bi), 0.f) & 0xffffu); } }
    WAIT_BAR(0);
}

__device__ __forceinline__ void sample_unit(int b, int h, const float* ck, const float* cv, const int* pt, const bf16_t* Qb, const bf16_t* Kb, const bf16_t* Vb, const bf16_t* Ub,
                                            const float* gs, const float* wsp, const float* bsp, bf16_t* MIX, const float* subln, float lam, LAS unsigned char* lds) {
    int tid = threadIdx.x; const int wid = __builtin_amdgcn_readfirstlane(tid >> 6);
    asm volatile("" : "+v"(tid));
    const int lane = tid & 63, fr = lane & 15, fq = lane >> 4;
    LAS float* P = (LAS float*)(lds + wid * 4096);
    LAS float* Fv = P + 512;
    const LAS float* btl = (const LAS float*)(lds + L_BTAB);
    LAS float* part = (LAS float*)(lds + 32768);
    bf16x8 qf[2][2];
#pragma unroll
    for (int mi = 0; mi < 2; ++mi)
#pragma unroll
        for (int kk = 0; kk < 2; ++kk) { bf16x8 z = (bf16x8){0, 0, 0, 0, 0, 0, 0, 0};
            if (fr < 8) z = *(const bf16x8*)(Qb + (size_t)(MP + b * 8 + fr) * AW + (2 * h + mi) * 64 + 32 * kk + 8 * fq);
            qf[mi][kk] = z; }
    float m[2] = {-INFINITY, -INFINITY}, ls[2] = {0.f, 0.f};
    f32x2 o[16];
#pragma unroll
    for (int i = 0; i < 16; ++i) o[i] = (f32x2){0.f, 0.f};
    LAS int* pids = (LAS int*)(P + 640);
    if (lane < 8) pids[lane] = pt[b * NPAGES + wid * 8 + lane];
    LDS_WAIT(); asm volatile("" ::: "memory");
    f32x4 kr[2][2][2][2];
    const __amdgpu_buffer_rsrc_t rk = __builtin_amdgcn_make_buffer_rsrc((void*)ck, 0, 0x7fffffff, 0x00020000), rv = __builtin_amdgcn_make_buffer_rsrc((void*)cv, 0, 0x7fffffff, 0x00020000);
    const int kvoff = fr * (AW * 4) + fq * 32, vvoff = lane * 8;
#define LOAD_K(nb_) do { const int pid_ = __builtin_amdgcn_readfirstlane(pids[(nb_) >> 2]); const int kro_ = (pid_ * PAGE + ((nb_) & 3) * 32) * (AW * 4) + (2 * h) * 256; \
        _Pragma("unroll") for (int kb = 0; kb < 2; ++kb) _Pragma("unroll") for (int mi = 0; mi < 2; ++mi) _Pragma("unroll") for (int kk = 0; kk < 2; ++kk) { \
            const int so_ = kro_ + kb * 16 * (AW * 4) + mi * 256 + kk * 128; \
            kr[kb][mi][kk][0] = __builtin_bit_cast(f32x4, __builtin_amdgcn_raw_buffer_load_b128(rk, kvoff, so_, 2)); kr[kb][mi][kk][1] = __builtin_bit_cast(f32x4, __builtin_amdgcn_raw_buffer_load_b128(rk, kvoff + 16, so_, 2)); } } while (0)
    LOAD_K(0);
    f32x2 va[16], vb[16];
#define LOAD_V(dst, nb_, half_) do { const int pid_ = __builtin_amdgcn_readfirstlane(pids[(nb_) >> 2]); const int vro_ = (pid_ * PAGE + ((nb_) & 3) * 32 + 16 * (half_)) * (AW * 4) + h * 512; \
        _Pragma("unroll") for (int k = 0; k < 16; ++k) dst[k] = __builtin_bit_cast(f32x2, __builtin_amdgcn_raw_buffer_load_b64(rv, vvoff, vro_ + k * (AW * 4), 2)); } while (0)
#define PV_HALF(src, half_) do { _Pragma("unroll") for (int k = 0; k < 16; ++k) { const LAS f32x4* pp = (const LAS f32x4*)(P + (16 * (half_) + k) * 16); const f32x4 p0 = pp[0], p1 = pp[1], p2 = pp[2], p3 = pp[3]; \
        _Pragma("unroll") for (int j = 0; j < 4; ++j) { o[j] += src[k] * p0[j]; o[4 + j] += src[k] * p1[j]; o[8 + j] += src[k] * p2[j]; o[12 + j] += src[k] * p3[j]; } \
        if (k & 1) __builtin_amdgcn_sched_barrier(0); } } while (0)
    LOAD_V(va, 0, 0);
#pragma unroll 1
    for (int nb = 0; nb < 32; ++nb) {
        const int kpos0 = (wid * 8 + (nb >> 2)) * PAGE + (nb & 3) * 32;
        f32x4 s[2][2];
#pragma unroll
        for (int kb = 0; kb < 2; ++kb)
#pragma unroll
            for (int mi = 0; mi < 2; ++mi) { f32x4 a = (f32x4){0.f, 0.f, 0.f, 0.f};
#pragma unroll
                for (int kk = 0; kk < 2; ++kk) { const f32x4 x = kr[kb][mi][kk][0], y = kr[kb][mi][kk][1];
                    u32x4 w; w.x = cvt_pk_bf16(x[0], x[1]); w.y = cvt_pk_bf16(x[2], x[3]); w.z = cvt_pk_bf16(y[0], y[1]); w.w = cvt_pk_bf16(y[2], y[3]);
                    a = __builtin_amdgcn_mfma_f32_16x16x32_bf16(__builtin_bit_cast(bf16x8, w), qf[mi][kk], a, 0, 0, 0); }
                s[kb][mi] = a; }
        const int nbn = (nb + 1 < 32) ? nb + 1 : 31;
        LOAD_K(nbn);
        LOAD_V(vb, nb, 1);
#pragma unroll
        for (int mi = 0; mi < 2; ++mi) { const LAS float* bt = btl + (2 * h + mi) * 128;
            if (kpos0 > 8048) {
#pragma unroll
                for (int kb = 0; kb < 2; ++kb)
#pragma unroll
                    for (int j = 0; j < 4; ++j) { int d = SEQ + fr - (kpos0 + 16 * kb + 4 * fq + j); d = d > 127 ? 127 : d; s[kb][mi][j] += bt[d]; }
            } else { const float b31 = bt[127]; s[0][mi] += b31; s[1][mi] += b31; }
        }
#pragma unroll
        for (int mi = 0; mi < 2; ++mi) {
            float bm = __builtin_fmaxf(MX3(s[0][mi][0], s[0][mi][1], s[0][mi][2]), MX3(s[0][mi][3], s[1][mi][0], s[1][mi][1])); bm = MX3(bm, s[1][mi][2], s[1][mi][3]);
            bm = __builtin_fmaxf(bm, __shfl_xor(bm, 16)); bm = __builtin_fmaxf(bm, __shfl_xor(bm, 32));
            const float mnew = __builtin_fmaxf(m[mi], bm); const float fsc = __builtin_amdgcn_exp2f(m[mi] - mnew); m[mi] = mnew; ls[mi] *= fsc;
#pragma unroll
            for (int kb = 0; kb < 2; ++kb)
#pragma unroll
                for (int j = 0; j < 4; ++j) { const float p = __builtin_amdgcn_exp2f(s[kb][mi][j] - mnew); ls[mi] += p; if (fr < 8) P[(16 * kb + 4 * fq + j) * 16 + mi * 8 + fr] = p; }
            if (fr < 8 && fq == 0) Fv[mi * 8 + fr] = fsc;
        }
        LDS_WAIT(); asm volatile("" ::: "memory");
        { const LAS f32x4* fp = (const LAS f32x4*)Fv; const f32x4 f0 = fp[0], f1 = fp[1], f2 = fp[2], f3 = fp[3];
#pragma unroll
          for (int j = 0; j < 4; ++j) { o[j] *= f0[j]; o[4 + j] *= f1[j]; o[8 + j] *= f2[j]; o[12 + j] *= f3[j]; } }
        PV_HALF(va, 0);
        asm volatile("" ::: "memory");
        LOAD_V(va, nbn, 0);
        PV_HALF(vb, 1);
        LDS_WAIT(); asm volatile("" ::: "memory");
    }
#undef LOAD_V
#undef PV_HALF
#undef LOAD_K
#pragma unroll
    for (int mi = 0; mi < 2; ++mi) { float l = ls[mi]; l += __shfl_xor(l, 16); l += __shfl_xor(l, 32);
        if (fr < 8 && fq == 0) { part[wid * SPART_F + mi * 8 + fr] = m[mi]; part[wid * SPART_F + 16 + mi * 8 + fr] = l; } }
#pragma unroll
    for (int i = 0; i < 16; ++i) *(LAS f32x2*)(part + wid * SPART_F + 32 + i * 128 + 2 * lane) = o[i];
    __syncthreads();
    int tidF = tid; asm volatile("" : "+v"(tidF));
    LAS float* tot = (LAS float*)lds;
    { const int d = tidF & 127, qg = tidF >> 7;
#pragma unroll
      for (int e = 0; e < 4; ++e) { const int qm = qg * 4 + e; float mx = -INFINITY;
#pragma unroll
          for (int w = 0; w < 8; ++w) mx = __builtin_fmaxf(mx, part[w * SPART_F + qm]);
          float a = 0.f, l = 0.f;
#pragma unroll
          for (int w = 0; w < 8; ++w) { const float f = __builtin_amdgcn_exp2f(part[w * SPART_F + qm] - mx); a += f * part[w * SPART_F + 32 + qm * 128 + d]; l += f * part[w * SPART_F + 16 + qm]; }
          tot[32 + qm * 128 + d] = a; if (d == 0) { tot[qm] = mx; tot[16 + qm] = l; } } }
    LAS float* SN = (LAS float*)(lds + 16384);
    LAS float* W0 = SN + 128, *LI = W0 + 16, *PJ = LI + 16;
    if (tidF < 128) { const int mi = tidF >> 6, q = (tidF >> 3) & 7, j = tidF & 7; float sv = -INFINITY;
        if (j <= q) { const bf16_t* qp = Qb + (size_t)(MP + b * 8 + q) * AW + (2 * h + mi) * 64; const bf16_t* kp = Kb + (size_t)(MP + b * 8 + j) * AW + (2 * h + mi) * 64; float a = 0.f;
            for (int d = 0; d < 64; ++d) a += bf2f(qp[d]) * bf2f(kp[d]);
            sv = a + btl[(2 * h + mi) * 128 + (q - j)]; }
        SN[(mi * 8 + q) * 8 + j] = sv; }
    __syncthreads();
    if (tidF < 16) { const int qm = tidF; float mx = tot[qm];
        for (int j = 0; j < 8; ++j) mx = __builtin_fmaxf(mx, SN[qm * 8 + j]);
        const float w0 = __builtin_amdgcn_exp2f(tot[qm] - mx); float l = w0 * tot[16 + qm];
        for (int j = 0; j < 8; ++j) { const float p = __builtin_amdgcn_exp2f(SN[qm * 8 + j] - mx); PJ[qm * 8 + j] = p; l += p; }
        W0[qm] = w0; LI[qm] = 1.f / l; }
    __syncthreads();
    { const int q = tidF >> 6, d = 2 * (tidF & 63); float v[2];
#pragma unroll
      for (int e = 0; e < 2; ++e) { float om[2];
#pragma unroll
          for (int mi = 0; mi < 2; ++mi) { const int qm = mi * 8 + q; float a = W0[qm] * tot[32 + qm * 128 + d + e];
              for (int j = 0; j <= q; ++j) a += PJ[qm * 8 + j] * bf2f(Vb[(size_t)(MP + b * 8 + j) * AW + h * 128 + d + e]);
              om[mi] = a * LI[qm]; }
          v[e] = om[0] - lam * om[1]; }
      const float ss = wave_sum(v[0] * v[0] + v[1] * v[1]); const float sc = __builtin_amdgcn_rsqf(ss * (1.f / 128.f) + EPS) * (1.f - LAM_INIT);
      *(unsigned*)(MIX + (size_t)(MP + b * 8 + q) * DM + h * 128 + d) = cvt_pk_bf16(v[0] * sc * subln[d], v[1] * sc * subln[d + 1]); }
#pragma unroll
    for (int e2 = 0; e2 < 2; ++e2) { const int e = tidF + 512 * e2, i = e >> 7, ch = h * 128 + (e & 127); float a = bsp[h * 128 + i];
        for (int j = 0; j <= i; ++j) a += wsp[(h * 128 + i) * 128 + j] * gs[(size_t)(b * 8 + j) * AW + ch];
        const float uu = bf2f(Ub[(size_t)(MP + b * 8 + i) * AW + ch]);
        MIX[(size_t)(MP + b * 8 + i) * DM + 512 + ch] = (bf16_t)(cvt_pk_bf16(uu * a, 0.f) & 0xffffu); }
    __syncthreads();
}
#undef MX3
#undef WAIT_BAR
}

__global__ void __launch_bounds__(NWAVES * 64, 2) mega_fwd(Args args) {
    extern __shared__ __attribute__((aligned(16))) unsigned char lds_raw[];
    Frame F;
    F.lds = (LAS unsigned char*)lds_raw;
    F.MISC = (volatile LAS unsigned*)(F.lds + MISC_OFF);
    F.tid = threadIdx.x; F.lane = F.tid & 63; F.wave = __builtin_amdgcn_readfirstlane(F.tid >> 6);
    F.G = gridDim.x; { const int bx = blockIdx.x; F.vcu = (F.G % 8 == 0) ? (bx % 8) * (F.G / 8) + bx / 8 : bx; }
    F.ws = args.ws; F.out = args.out; F.ctl = (unsigned*)(args.ws + WS_CTL);
    for (int u = F.tid; u < (LDS_BYTES - LDSCTL_OFF) / 4; u += NWAVES * 64) ((LAS unsigned*)(F.lds + LDSCTL_OFF))[u] = 0u;
    __syncthreads();
    XcdBarrier bar; bar.bar = F.ctl + CW_BAR + args.li * XCD_BAR_WORDS; bar.x = 0; bar.st = nullptr;
    if (N_LAUNCHES != PER_PHASE) bar = xcd_barrier_post(F.ctl + CW_BAR + args.li * XCD_BAR_WORDS, F.MISC + 8);
#define GRID_BAR() do { if (N_LAUNCHES != PER_PHASE) xcd_barrier(bar); } while (0)
    const int lo = args.ph_lo, hi = args.ph_hi;
#define IN(k) (lo <= (k) && (k) < hi)
#define BOTH(k) (IN(k) && IN((k) + 1))
    bf16_t* XB = (bf16_t*)(F.ws + WS_XB); bf16_t* Hb = (bf16_t*)(F.ws + WS_H); bf16_t* MIXb = (bf16_t*)(F.ws + WS_MIX);
    bf16_t *Qb = (bf16_t*)(F.ws + WS_Q), *Kb = (bf16_t*)(F.ws + WS_K), *Vb = (bf16_t*)(F.ws + WS_V), *Ub = (bf16_t*)(F.ws + WS_U), *GVb = (bf16_t*)(F.ws + WS_GV);
    float* SSQ = (float*)(F.ws + WS_SSQ);
    const LAS float* rstab = (const LAS float*)(F.lds + RSTAB_OFF);

    if (IN(0)) { p0_prologue(F, args); if (BOTH(0)) GRID_BAR(); }
    if (IN(1)) {
        pg8::Gemm g{XB, (const bf16_t*)(F.ws + WS_WGU1), MT, NGU, DM}; pg8::StaticOrder S; S.init(MT, NGU, F.G, (int)blockIdx.x);
        rstab_fill(F, S);
        pg8::EpiSwiGLU E{Hb, rstab};
        pg8::gemm_phase<pg8::EpiSwiGLU, pg8::StaticOrder, true, true>(F.lds, g, S, E);
        if (BOTH(1)) GRID_BAR();
    }
    if (IN(2)) {
        pg8::Gemm g{Hb, (const bf16_t*)(F.ws + WS_WD1), MP, DM, DFF}; pg8::StaticOrder S; S.init(MP, DM, F.G, (int)blockIdx.x);
        pg8::EpiResid<0> E{args.in[I_XP], nullptr, XB, SSQ, 0.5f};
        pg8::gemm_phase<pg8::EpiResid<0>, pg8::StaticOrder, true, true>(F.lds, g, S, E);
        mini_gemm_resid<0>(F, Hb, (const bf16_t*)(F.ws + WS_WD1), DFF, args.in[I_XS], MP, nullptr, XB, 0.5f);
        if (BOTH(2)) GRID_BAR();
    }
    if (IN(3)) {
        pg8::Gemm g{XB, (const bf16_t*)(F.ws + WS_WIN), MT, NIN, DM}; pg8::StaticOrder S; S.init(MT, NIN, F.G, (int)blockIdx.x);
        rstab_fill(F, S);
        pg8::EpiWin E{Qb, Kb, Vb, Ub, GVb, F.out, args.in[I_GNORM], rstab, (LAS float*)(F.lds + GX_OFF)};
        pg8::gemm_phase<pg8::EpiWin, pg8::StaticOrder, true, true>(F.lds, g, S, E);
        if (BOTH(3)) GRID_BAR();
    }
    if (IN(4)) {
        float lam;
        { const float a = wave_sum(args.in[I_LQ1][F.lane] * args.in[I_LK1][F.lane]), c = wave_sum(args.in[I_LQ2][F.lane] * args.in[I_LK2][F.lane]); lam = __expf(a) - __expf(c) + LAM_INIT; }
        { const float* BT = (const float*)(F.ws + WS_BTAB); LAS float* btl = (LAS float*)(F.lds + att::L_BTAB); for (int e = F.tid; e < 1024; e += 512) btl[e] = BT[e]; }
        const int qid = (F.vcu * 8) / F.G;
        unsigned* qh = F.ctl + CW_Q + 64 * qid;
        volatile LAS unsigned* QW = F.MISC + 16;
        if (F.tid == 0) QW[0] = __hip_atomic_fetch_add(qh, 1u, __ATOMIC_RELAXED, __HIP_MEMORY_SCOPE_AGENT);
        __syncthreads();
#define NEXT_TICKET(body) do { unsigned tn_ = 0u; if (F.tid == 0) tn_ = __hip_atomic_fetch_add(qh, 1u, __ATOMIC_RELAXED, __HIP_MEMORY_SCOPE_AGENT); body; if (F.tid == 0) QW[0] = tn_; __syncthreads(); t = __builtin_amdgcn_readfirstlane((int)QW[0]); } while (0)
        int t = __builtin_amdgcn_readfirstlane((int)QW[0]);
        while (t < 16) { const int u = qid * 16 + t;
            NEXT_TICKET(att::sample_unit(u >> 2, u & 3, args.in[I_CK], args.in[I_CV], args.page_table, Qb, Kb, Vb, Ub, F.out + O_GS, args.in[I_WS], args.in[I_BS], MIXb, args.in[I_SUBLN], lam, F.lds)); }
        while (t < 80) { NEXT_TICKET(att::attn_unit(qid >> 2, qid & 3, 79 - t, Qb, Kb, Vb, MIXb, args.in[I_SUBLN], lam, F.lds)); }
        while (t < 96) { const int c = qid * 16 + (t - 80);
            NEXT_TICKET(for (int g = 0; g < 4; ++g) att::spatial_unit(c, g, GVb, Ub, (const bf16_t*)(F.ws + WS_WTRIL), args.in[I_BS], MIXb, F.lds)); }
#undef NEXT_TICKET
        if (BOTH(4)) GRID_BAR();
    }
    if (IN(5)) {
        pg8::Gemm g{MIXb, (const bf16_t*)(F.ws + WS_WOUT), MP, DM, DM}; pg8::StaticOrder S; S.init(MP, DM, F.G, (int)blockIdx.x);
        pg8::EpiResid<1> E{nullptr, nullptr, XB, SSQ, 1.0f};
        pg8::gemm_phase<pg8::EpiResid<1>, pg8::StaticOrder, true, true>(F.lds, g, S, E);
        mini_gemm_resid<1>(F, MIXb, (const bf16_t*)(F.ws + WS_WOUT), DM, nullptr, 0, nullptr, XB, 1.0f);
        if (BOTH(5)) GRID_BAR();
    }
    if (IN(6)) {
        pg8::Gemm g{XB, (const bf16_t*)(F.ws + WS_WGU2), MT, NGU, DM}; pg8::StaticOrder S; S.init(MT, NGU, F.G, (int)blockIdx.x);
        rstab_fill(F, S);
        pg8::EpiSwiGLU E{Hb, rstab};
        pg8::gemm_phase<pg8::EpiSwiGLU, pg8::StaticOrder, true, true>(F.lds, g, S, E);
        if (BOTH(6)) GRID_BAR();
    }
    if (IN(7)) {
        pg8::Gemm g{Hb, (const bf16_t*)(F.ws + WS_WD2), MP, DM, DFF}; pg8::StaticOrder S; S.init(MP, DM, F.G, (int)blockIdx.x);
        pg8::EpiResid<2> E{nullptr, F.out, XB, SSQ, 0.5f};
        pg8::gemm_phase<pg8::EpiResid<2>, pg8::StaticOrder, true, true>(F.lds, g, S, E);
        mini_gemm_resid<2>(F, Hb, (const bf16_t*)(F.ws + WS_WD2), DFF, nullptr, 0, F.out, XB, 0.5f);
        if (BOTH(7)) GRID_BAR();
    }
    if (IN(8)) {
        const unsigned bad = (N_LAUNCHES != PER_PHASE) ? __hip_atomic_load(F.ctl + CW_BAR + XB_TMO, __ATOMIC_RELAXED, __HIP_MEMORY_SCOPE_AGENT) : 0u;
        const int gw = F.vcu * NWAVES + F.wave, NGW = F.G * NWAVES; const float* gf = args.in[I_NFIN];
        const int ln9 = (int)__builtin_amdgcn_mbcnt_hi(~0u, __builtin_amdgcn_mbcnt_lo(~0u, 0u));
        for (int m = gw; m < MT; m += NGW) {
            const f32x4* p = (const f32x4*)(SSQ + (size_t)m * 16); const f32x4 s4 = (p[0] + p[1]) + (p[2] + p[3]);
            float rs = __builtin_amdgcn_rsqf(((s4[0] + s4[1]) + (s4[2] + s4[3])) * (1.f / DM) + EPS);
            if (bad) rs = __builtin_nanf("");
            f32x4* xr = (f32x4*)(F.out + (size_t)m * DM) + ln9;
#pragma unroll
            for (int j = 0; j < 4; ++j) { const f32x4 gg = ((const f32x4*)gf)[ln9 + 64 * j]; xr[64 * j] = xr[64 * j] * rs * gg; }
        }
    }
#undef IN
#undef BOTH
#undef GRID_BAR
}

extern "C" void kernel_launch(void* const* d_in, const int* in_sizes, int n_in, void* d_out, int out_size, void* d_ws, size_t ws_size, hipStream_t stream) {
    static int grid = 0;
    if (grid == 0) {
        if (n_in != 24 || (size_t)out_size != O_END || ws_size < WS_END) { fprintf(stderr, "kernel_launch: unexpected sizes (n_in %d out %d ws %zu)\n", n_in, out_size, ws_size); grid = -1; return; }
        int dev = 0, cus = 0, per_cu = 0;
        if (hipGetDevice(&dev) != hipSuccess || hipDeviceGetAttribute(&cus, hipDeviceAttributeMultiprocessorCount, dev) != hipSuccess) { grid = -1; return; }
        if (hipFuncSetAttribute((const void*)mega_fwd, hipFuncAttributeMaxDynamicSharedMemorySize, LDS_BYTES) != hipSuccess) { fprintf(stderr, "kernel_launch: hipFuncSetAttribute failed\n"); grid = -1; return; }
        if (hipOccupancyMaxActiveBlocksPerMultiprocessor(&per_cu, (const void*)mega_fwd, NWAVES * 64, LDS_BYTES) != hipSuccess || per_cu < 1) { fprintf(stderr, "kernel_launch: occupancy query reports %d\n", per_cu); }
        (void)hipGetLastError();
        grid = cus;
        if (grid != 256) { fprintf(stderr, "kernel_launch: built for 256 CUs, found %d\n", cus); grid = -1; return; }
    }
    if (grid < 0) return;
    if (hipMemsetAsync((char*)d_ws + WS_CTL, 0, CTL_ZERO_BYTES, stream) != hipSuccess) return;
    Args a{};
    for (int i = 0; i < 24; ++i) a.in[i] = (const float*)d_in[i];
    a.page_table = (const int*)d_in[I_PT]; a.out = (float*)d_out; a.ws = (unsigned char*)d_ws;
    if (N_LAUNCHES == 1) { a.ph_lo = 0; a.ph_hi = PER_PHASE; a.li = 0; hipLaunchKernelGGL(mega_fwd, dim3(grid), dim3(NWAVES * 64), LDS_BYTES, stream, a); }
    else { for (int li = 0; li < PER_PHASE; ++li) { a.ph_lo = li; a.ph_hi = li + 1; a.li = 0; hipLaunchKernelGGL(mega_fwd, dim3(grid), dim3(NWAVES * 64), LDS_BYTES, stream, a); } }
    const hipError_t le = hipPeekAtLastError();
    if (le != hipSuccess) fprintf(stderr, "kernel_launch: launch failed: %s\n", hipGetErrorName(le));
}
```

```cpp
#include <hip/hip_runtime.h>
#include <cstdio>
#include <cstdint>

#define LAS __attribute__((address_space(3)))
#define GAS __attribute__((address_space(1)))
typedef unsigned short bf16_t;
typedef short bf16x8 __attribute__((ext_vector_type(8)));
typedef short s16x4 __attribute__((ext_vector_type(4)));
typedef float f32x2 __attribute__((ext_vector_type(2)));
typedef float f32x4 __attribute__((ext_vector_type(4)));
typedef float f32x16 __attribute__((ext_vector_type(16)));
typedef unsigned u32x2 __attribute__((ext_vector_type(2)));
typedef unsigned u32x4 __attribute__((ext_vector_type(4)));

constexpr int DM = 1024, SEQ = 8192, MP = 16384, MS = 256, MT = 16640, DFF = 2816, NGU = 5632, NIN = 2560, AW = 512;
constexpr int NPAGES = 64, PAGE = 128;
constexpr float EPS = 1e-6f, LOG2E = 1.4426950408889634f, C2 = 0.125f * 1.4426950408889634f;
constexpr float LAM_INIT = 0.2f;
constexpr int NWAVES = 8;
#ifndef MK_N_LAUNCHES
#define MK_N_LAUNCHES 1
#endif
constexpr int N_LAUNCHES = MK_N_LAUNCHES;
constexpr int PER_PHASE = 9;

constexpr size_t O_Y = 0, O_KP = (size_t)MT * DM, O_VP = O_KP + (size_t)MP * AW, O_KS = O_VP + (size_t)MP * AW, O_VS = O_KS + (size_t)MS * AW, O_GS = O_VS + (size_t)MS * AW, O_END = O_GS + (size_t)MS * AW;

constexpr size_t MiB = 1u << 20;
constexpr size_t WS_CTL = 0, CTL_ZERO_BYTES = 1 * MiB;
constexpr size_t WS_WGU1 = 2 * MiB, WS_WD1 = 13 * MiB, WS_WIN = 19 * MiB, WS_WOUT = 24 * MiB, WS_WGU2 = 26 * MiB, WS_WD2 = 37 * MiB;
constexpr size_t WS_WTRIL = 43 * MiB, WS_BTAB = 43 * MiB + 256 * 1024, WS_SSQ = 44 * MiB, WS_SPART = 46 * MiB;
constexpr size_t WS_XB = 64 * MiB, WS_Q = 100 * MiB, WS_K = 120 * MiB, WS_V = 140 * MiB, WS_U = 160 * MiB, WS_GV = 180 * MiB, WS_MIX = 200 * MiB;
constexpr size_t WS_X1 = 240 * MiB, WS_H = 320 * MiB, WS_END = 416 * MiB;
constexpr int CW_TMO = 0, CW_BAR = 4096, CW_Q = 16384;
constexpr int SPART_F = 16 + 16 + 16 * 128;

constexpr int RING_BYTES = 131072;
constexpr int LDSCTL_OFF = RING_BYTES, MISC_OFF = LDSCTL_OFF + 320;
constexpr int RSTAB_OFF = RING_BYTES + 512;
constexpr int GX_OFF = RSTAB_OFF + 6144;
constexpr int LDS_BYTES = 147456;
static_assert(GX_OFF + 8192 <= LDS_BYTES, "LDS map");

__device__ __forceinline__ unsigned cvt_pk_bf16(float lo, float hi) { unsigned r; asm("v_cvt_pk_bf16_f32 %0, %1, %2" : "=v"(r) : "v"(lo), "v"(hi)); return r; }
__device__ __forceinline__ float bf2f(bf16_t v) { return __uint_as_float((unsigned)v << 16); }
__device__ __forceinline__ float silu_f(float x) { return x * __builtin_amdgcn_rcpf(1.f + __builtin_amdgcn_exp2f(-x * LOG2E)); }
__device__ __forceinline__ float gelu_f(float x) { const float z2 = x * (1.5957691216f + 0.0713548163f * x * x); return x * __builtin_amdgcn_rcpf(1.f + __builtin_amdgcn_exp2f(-z2 * LOG2E)); }
__device__ __forceinline__ float wave_sum(float v) {
#pragma unroll
    for (int o = 1; o < 64; o <<= 1) v += __shfl_xor(v, o);
    return v;
}
#define LDS_WAIT() asm volatile("s_waitcnt lgkmcnt(0)" ::: "memory")
#define VM_WAIT() asm volatile("s_waitcnt vmcnt(0)" ::: "memory")

namespace pg8 {
constexpr int BM = 256, BK = 64, HALF = 128, HTB = HALF * BK * 2, STAGE_BYTES = 8 * HTB, NXCD = 8, WGM = 8;
__host__ __device__ __forceinline__ int lds_byte(int r, int c) { const int st = (r >> 4) * 2 + (c >> 5), rr = r & 15, cc = c & 31, ob = rr * 64 + cc * 2; return st * 1024 + (ob ^ (((ob >> 9) & 1) << 5)); }
__host__ __device__ __forceinline__ void stage_rc(int b, int& R, int& C) { const int st = b / 1024, sb = b % 1024, swz = sb ^ (((sb >> 9) & 1) << 5); R = (st >> 1) * 16 + swz / 64; C = (st & 1) * 32 + (swz % 64) / 2; }
__host__ __device__ __forceinline__ int perm32(int rho) { const int n = rho >> 4, i = rho & 15; return 8 * (i >> 2) + 4 * n + (i & 3); }

struct Unit { int pm, pn, idx; };
struct Gemm { const bf16_t* A; const bf16_t* Bt; int M, N, K; };

struct StaticOrder {
    int nM, nN, nwg, G, c;
    __host__ __device__ void init(int M, int N, int G_, int c_) { nM = M / BM; nN = N / BM; nwg = nM * nN; G = G_; c = c_; }
    __host__ __device__ bool next(int i, Unit& u) const {
        const long L = (long)i * G + c; if (L >= nwg) return false;
        int wgid = (int)L; { const int q = nwg / NXCD, r = nwg % NXCD, xcd = wgid % NXCD, off = wgid / NXCD; wgid = (xcd < r ? xcd * (q + 1) : r * (q + 1) + (xcd - r) * q) + off; }
        const int nig = WGM * nN, gid = wgid / nig, fm = gid * WGM, gsz = (nM - fm) < WGM ? (nM - fm) : WGM;
        u.pm = fm + ((wgid % nig) % gsz); u.pn = (wgid % nig) / gsz; u.idx = i; return true;
    }
    __device__ __forceinline__ void a_ready(const Unit&) const {}
    __device__ __forceinline__ void done(const Unit&) const {}
};

struct EpiSwiGLU {
    static constexpr bool PERM = true, AFTER_DRAIN = false;
    bf16_t* H; const LAS float* rstab;
    __device__ __forceinline__ void operator()(const f32x4 (&acc)[2][2][4][2], const Unit& u, int wr, int wc, int fr, int fq) const {
        const int col0 = u.pn * 128 + wc * 32 + 8 * fq;
#pragma unroll
        for (int ai = 0; ai < 2; ++ai)
#pragma unroll
            for (int m = 0; m < 4; ++m) {
                const int rin = ai * HALF + wr * 64 + m * 16 + fr; const float rs = rstab[u.idx * 256 + rin];
                float h[8];
#pragma unroll
                for (int n = 0; n < 2; ++n)
#pragma unroll
                    for (int j = 0; j < 4; ++j) h[n * 4 + j] = silu_f(acc[ai][0][m][n][j] * rs) * (acc[ai][1][m][n][j] * rs);
                u32x4 w; w.x = cvt_pk_bf16(h[0], h[1]); w.y = cvt_pk_bf16(h[2], h[3]); w.z = cvt_pk_bf16(h[4], h[5]); w.w = cvt_pk_bf16(h[6], h[7]);
                *(u32x4*)(H + (size_t)(u.pm * BM + rin) * DFF + col0) = w;
            }
    }
};
template <int MODE> struct EpiResid {
    static constexpr bool PERM = true, AFTER_DRAIN = false;
    const float* xold; float* xnew; bf16_t* xb; float* ssq; float alpha;
    __device__ __forceinline__ void operator()(const f32x4 (&acc)[2][2][4][2], const Unit& u, int wr, int wc, int fr, int fq) const {
        const int col0 = u.pn * BM + wc * 32 + 8 * fq;
#pragma unroll
        for (int ai = 0; ai < 2; ++ai)
#pragma unroll
            for (int m = 0; m < 4; ++m) {
                const int row = u.pm * BM + ai * HALF + wr * 64 + m * 16 + fr; const size_t off = (size_t)row * DM + col0; float ss = 0.f;
#pragma unroll
                for (int bj = 0; bj < 2; ++bj) {
                    f32x4 o0, o1;
                    if (MODE == 0) { o0 = *(const f32x4*)(xold + off + bj * HALF); o1 = *(const f32x4*)(xold + off + bj * HALF + 4); }
                    else { const u32x4 w = *(const u32x4*)(xb + off + bj * HALF);
                        o0 = (f32x4){__uint_as_float(w.x << 16), __uint_as_float(w.x & 0xffff0000u), __uint_as_float(w.y << 16), __uint_as_float(w.y & 0xffff0000u)};
                        o1 = (f32x4){__uint_as_float(w.z << 16), __uint_as_float(w.z & 0xffff0000u), __uint_as_float(w.w << 16), __uint_as_float(w.w & 0xffff0000u)}; }
                    const f32x4 n0 = o0 + acc[ai][bj][m][0] * alpha, n1 = o1 + acc[ai][bj][m][1] * alpha;
                    ss += (n0[0] * n0[0] + n0[1] * n0[1]) + (n0[2] * n0[2] + n0[3] * n0[3]) + (n1[0] * n1[0] + n1[1] * n1[1]) + (n1[2] * n1[2] + n1[3] * n1[3]);
                    if (MODE == 2) { *(f32x4*)(xnew + off + bj * HALF) = n0; *(f32x4*)(xnew + off + bj * HALF + 4) = n1; }
                    else { u32x4 w; w.x = cvt_pk_bf16(n0[0], n0[1]); w.y = cvt_pk_bf16(n0[2], n0[3]); w.z = cvt_pk_bf16(n1[0], n1[1]); w.w = cvt_pk_bf16(n1[2], n1[3]);
                        *(u32x4*)(xb + off + bj * HALF) = w; }
                }
                ss += __shfl_xor(ss, 16); ss += __shfl_xor(ss, 32);
                if (fq == 0) ssq[(size_t)row * 16 + u.pn * 4 + wc] = ss;
                asm volatile("" ::: "memory");
            }
    }
};
struct EpiWin {
    static constexpr bool PERM = true, AFTER_DRAIN = false;
    bf16_t *Qb, *Kb, *Vb, *Ub, *GVb; float* out; const float* gnorm; const LAS float* rstab; LAS float* gx;
    __device__ __forceinline__ void operator()(const f32x4 (&acc)[2][2][4][2], const Unit& u, int wr, int wc, int fr, int fq) const {
        const int kind = u.pn >> 1;
        const int cbase = (u.pn & 1) * 256 + wc * 32 + 8 * fq;
        if (kind == 4) {
#pragma unroll
            for (int ai = 0; ai < 2; ++ai)
#pragma unroll
                for (int m = 0; m < 4; ++m) {
                    const int rin = ai * HALF + wr * 64 + m * 16 + fr; const float rs = rstab[u.idx * 256 + rin];
#pragma unroll
                    for (int bj = 0; bj < 2; ++bj) {
                        float ss = 0.f;
#pragma unroll
                        for (int n = 0; n < 2; ++n)
#pragma unroll
                            for (int j = 0; j < 4; ++j) { const float g = gelu_f(acc[ai][bj][m][n][j] * rs); ss += g * g; }
                        ss += __shfl_xor(ss, 16); ss += __shfl_xor(ss, 32);
                        if (fq == 0) gx[(rin * 2 + bj) * 4 + wc] = ss;
                    }
                }
            asm volatile("s_waitcnt lgkmcnt(0)\n\ts_barrier" ::: "memory");
        }
#pragma unroll
        for (int ai = 0; ai < 2; ++ai)
#pragma unroll
            for (int m = 0; m < 4; ++m) {
                const int rin = ai * HALF + wr * 64 + m * 16 + fr; const int row = u.pm * BM + rin; const float rs = rstab[u.idx * 256 + rin];
#pragma unroll
                for (int bj = 0; bj < 2; ++bj) {
                    const int col = cbase + bj * HALF;
                    f32x4 v0 = acc[ai][bj][m][0] * rs, v1 = acc[ai][bj][m][1] * rs;
                    bf16_t* dst;
                    if (kind == 0) { v0 = v0 * C2; v1 = v1 * C2; dst = Qb; }
                    else if (kind == 1 || kind == 2) {
                        dst = (kind == 1) ? Kb : Vb;
                        float* o = out + ((row < MP) ? ((kind == 1 ? O_KP : O_VP) + (size_t)row * AW) : ((kind == 1 ? O_KS : O_VS) + (size_t)(row - MP) * AW)) + col;
                        *(f32x4*)o = v0; *(f32x4*)(o + 4) = v1;
                    } else if (kind == 3) {
#pragma unroll
                        for (int j = 0; j < 4; ++j) { v0[j] = gelu_f(v0[j]); v1[j] = gelu_f(v1[j]); }
                        dst = Ub;
                    } else {
                        const LAS f32x4* gp = (const LAS f32x4*)(gx + (rin * 2 + bj) * 4); const f32x4 p = *gp;
                        const float rg = __builtin_amdgcn_rsqf(((p[0] + p[1]) + (p[2] + p[3])) * (1.f / 128.f) + EPS);
                        const f32x4 g0 = *(const f32x4*)(gnorm + col), g1 = *(const f32x4*)(gnorm + col + 4);
#pragma unroll
                        for (int j = 0; j < 4; ++j) { v0[j] = gelu_f(v0[j]) * rg * g0[j]; v1[j] = gelu_f(v1[j]) * rg * g1[j]; }
                        dst = GVb;
                        if (row >= MP) { float* o = out + O_GS + (size_t)(row - MP) * AW + col; *(f32x4*)o = v0; *(f32x4*)(o + 4) = v1; }
                    }
                    u32x4 w; w.x = cvt_pk_bf16(v0[0], v0[1]); w.y = cvt_pk_bf16(v0[2], v0[3]); w.z = cvt_pk_bf16(v1[0], v1[1]); w.w = cvt_pk_bf16(v1[2], v1[3]);
                    *(u32x4*)(dst + (size_t)row * AW + col) = w;
                }
                asm volatile("" ::: "memory");
            }
    }
};

template <class Epi, class Sched, bool ALIGN_EPI = false, bool SP2 = true>
__device__ __forceinline__ void gemm_phase(LAS unsigned char* lds, const Gemm g, const Sched& S, const Epi& E) {
    const int tid = threadIdx.x, wid = __builtin_amdgcn_readfirstlane(tid >> 6), lane = tid & 63, wr = wid >> 2, wc = wid & 3, fr = lane & 15, fq = lane >> 4;
    const int K = g.K, nt = K / BK;
    unsigned voffA[2], voffB[2];
#pragma unroll
    for (int i = 0; i < 2; ++i) { int R, C; stage_rc(tid * 16 + i * 8192, R, C); const int Rb = Epi::PERM ? ((R & ~31) + perm32(R & 31)) : R;
        voffA[i] = (unsigned)(R * K + C) * 2u; voffB[i] = (unsigned)(Rb * K + C) * 2u; }
    const size_t kstep = (size_t)(BK * 2);
    const size_t hstep = (size_t)HALF * K * 2;
    const size_t tstep = 2 * hstep;
    const unsigned ldsw = (unsigned)wid * 1024u;
    const int aoff = lds_byte(wr * 64 + fr, fq * 8), boff = lds_byte(wc * 32 + fr, fq * 8);
#define PG8_SA(b, h) (((b) * 2 + (h)) * HTB)
#define PG8_SB(b, h) ((4 + (b) * 2 + (h)) * HTB)
#define PG8_STAGE(bufoff, gbase, voff) do { _Pragma("unroll") for (int _i = 0; _i < 2; ++_i) \
        __builtin_amdgcn_global_load_lds((const unsigned*)((const char*)(gbase) + (voff)[_i]), (LAS unsigned*)(lds + (bufoff) + ldsw + _i * 8192), 16, 0, 0); } while (0)
#define PG8_LDA(dst, b, h) do { _Pragma("unroll") for (int m = 0; m < 4; ++m) _Pragma("unroll") for (int k = 0; k < 2; ++k) dst[m][k] = *(const LAS bf16x8*)(lds + PG8_SA(b, h) + aoff + m * 2048 + k * 1024); } while (0)
#define PG8_LDB(dst, b, h) do { _Pragma("unroll") for (int n = 0; n < 2; ++n) _Pragma("unroll") for (int k = 0; k < 2; ++k) dst[n][k] = *(const LAS bf16x8*)(lds + PG8_SB(b, h) + boff + n * 2048 + k * 1024); } while (0)
#define PG8_MMA(ai, bj, At, Bt) do { __builtin_amdgcn_s_setprio(1); _Pragma("unroll") for (int m = 0; m < 4; ++m) _Pragma("unroll") for (int n = 0; n < 2; ++n) _Pragma("unroll") for (int k = 0; k < 2; ++k) \
        acc[ai][bj][m][n] = __builtin_amdgcn_mfma_f32_16x16x32_bf16(Bt[n][k], At[m][k], acc[ai][bj][m][n], 0, 0, 0); __builtin_amdgcn_s_setprio(0); } while (0)
#define PG8_WAIT_V(n) asm volatile("s_waitcnt vmcnt(" #n ")" ::: "memory")
#define PG8_WAIT_L(n) asm volatile("s_waitcnt lgkmcnt(" #n ")" ::: "memory")
#define PG8_BAR __builtin_amdgcn_s_barrier()
#define PG8_SCHED __builtin_amdgcn_sched_barrier(0)
    Unit cur, nxt; int ui = 0;
    if (!S.next(0, cur)) return;
    f32x4 acc[2][2][4][2];
#pragma unroll
    for (int a = 0; a < 2; ++a)
#pragma unroll
        for (int b = 0; b < 2; ++b)
#pragma unroll
            for (int m = 0; m < 4; ++m)
#pragma unroll
                for (int n = 0; n < 2; ++n) acc[a][b][m][n] = (f32x4){0.f, 0.f, 0.f, 0.f};
    bf16x8 At[4][2], B0[2][2], B1[2][2];
    const char* cA = (const char*)g.A + (size_t)cur.pm * tstep; const char* cB = (const char*)g.Bt + (size_t)cur.pn * tstep;
    S.a_ready(cur);
    PG8_STAGE(PG8_SB(0, 0), cB, voffB); PG8_STAGE(PG8_SB(0, 1), cB + hstep, voffB); PG8_STAGE(PG8_SA(0, 0), cA, voffA); PG8_STAGE(PG8_SA(0, 1), cA + hstep, voffA);
    if (wr == 1) PG8_BAR;
    PG8_WAIT_V(2); PG8_BAR;
    PG8_STAGE(PG8_SB(1, 0), cB + kstep, voffB); PG8_STAGE(PG8_SA(1, 0), cA + kstep, voffA); PG8_STAGE(PG8_SB(1, 1), cB + hstep + kstep, voffB);
    PG8_WAIT_V(6); PG8_BAR;
    for (;;) {
        const bool has_next = S.next(ui + 1, nxt);
        const char* nA = has_next ? (const char*)g.A + (size_t)nxt.pm * tstep : cA; const char* nB = has_next ? (const char*)g.Bt + (size_t)nxt.pn * tstep : cB;
        for (int t = 0; t < nt; t += 2) {
            const bool last = (t == nt - 2);
            const char* a1 = cA + (size_t)(t + 1) * kstep;
            const char* a2 = last ? nA : cA + (size_t)(t + 2) * kstep; const char* b2 = last ? nB : cB + (size_t)(t + 2) * kstep;
            const char* a3 = a2 + kstep; const char* b3 = b2 + kstep;
            if (last && has_next) S.a_ready(nxt);
            PG8_LDB(B0, 0, 0); PG8_LDB(B1, 0, 1); PG8_SCHED; PG8_LDA(At, 0, 0); PG8_STAGE(PG8_SA(1, 1), a1 + hstep, voffA);
            PG8_WAIT_V(8); PG8_WAIT_L(0); PG8_BAR; PG8_MMA(0, 0, At, B0); PG8_MMA(0, 1, At, B1); PG8_BAR; PG8_SCHED;
            PG8_LDA(At, 0, 1); PG8_STAGE(PG8_SB(0, 0), b2, voffB); PG8_STAGE(PG8_SB(0, 1), b2 + hstep, voffB); PG8_STAGE(PG8_SA(0, 0), a2, voffA);
            PG8_WAIT_V(8); PG8_WAIT_L(0); PG8_BAR; PG8_MMA(1, 0, At, B0); PG8_MMA(1, 1, At, B1); PG8_BAR; PG8_SCHED;
            PG8_LDB(B0, 1, 0); PG8_LDB(B1, 1, 1); PG8_SCHED; PG8_LDA(At, 1, 0); PG8_STAGE(PG8_SA(0, 1), a2 + hstep, voffA);
            PG8_WAIT_V(8); PG8_WAIT_L(0); PG8_BAR; PG8_MMA(0, 0, At, B0); PG8_MMA(0, 1, At, B1); PG8_BAR; PG8_SCHED;
            PG8_LDA(At, 1, 1); PG8_STAGE(PG8_SB(1, 0), b3, voffB); PG8_STAGE(PG8_SB(1, 1), b3 + hstep, voffB); PG8_STAGE(PG8_SA(1, 0), a3, voffA);
            PG8_WAIT_V(8); PG8_WAIT_L(0); PG8_BAR; PG8_MMA(1, 0, At, B0); PG8_MMA(1, 1, At, B1); PG8_BAR; PG8_SCHED;
        }
        if constexpr (ALIGN_EPI) { if (wr == 0) PG8_BAR; }
        E(acc, cur, wr, wc, fr, fq); S.done(cur);
        if (!has_next) break;
#pragma unroll
        for (int a = 0; a < 2; ++a)
#pragma unroll
            for (int b = 0; b < 2; ++b)
#pragma unroll
                for (int m = 0; m < 4; ++m)
#pragma unroll
                    for (int n = 0; n < 2; ++n) acc[a][b][m][n] = (f32x4){0.f, 0.f, 0.f, 0.f};
        cur = nxt; cA = nA; cB = nB; ++ui;
        if constexpr (ALIGN_EPI) { if (wr == 1) PG8_BAR; }
    }
    PG8_WAIT_V(0);
    if constexpr (!ALIGN_EPI) { if (wr == 0) PG8_BAR; }
    PG8_BAR;
#undef PG8_SA
#undef PG8_SB
#undef PG8_STAGE
#undef PG8_LDA
#undef PG8_LDB
#undef PG8_MMA
#undef PG8_WAIT_V
#undef PG8_WAIT_L
#undef PG8_BAR
#undef PG8_SCHED
}
}

#define XB_TMO      128
#define XB_XCNT(j)  (256  + 64 * (j))
#define XB_XSUB(j)  (1280 + 64 * (j))
#define XB_XGEN(j)  (2304 + 64 * (j))
#define XB_TOP      3328
#define XB_TOPGEN   3392
#define XCD_BAR_WORDS 3456
#define XB_SPIN_CAP (1u << 18)
__device__ __forceinline__ unsigned xb_ld(unsigned* p)              { return __hip_atomic_load(p, __ATOMIC_RELAXED, __HIP_MEMORY_SCOPE_AGENT); }
__device__ __forceinline__ unsigned xb_add(unsigned* p, unsigned v) { return __hip_atomic_fetch_add(p, v, __ATOMIC_RELAXED, __HIP_MEMORY_SCOPE_AGENT); }
__device__ __forceinline__ unsigned xb_xcc_id() { return (unsigned)__builtin_amdgcn_s_getreg((3 << 11) | 20) & 0xFu; }
#define XB_SPIN(cond, bar) do { unsigned _sp = 0; while (cond) { __builtin_amdgcn_s_sleep(1); \
    if ((++_sp & 255u) == 0u) { if (xb_ld(&(bar)[XB_TMO])) break; if (_sp > XB_SPIN_CAP) { atomicAdd(&(bar)[XB_TMO], 1u); break; } } } } while (0)
struct XcdBarrier { unsigned* bar; unsigned x; volatile LAS unsigned* st; };
__device__ __forceinline__ XcdBarrier xcd_barrier_post(unsigned* bar, volatile LAS unsigned* st) {
    XcdBarrier b; b.bar = bar; b.x = xb_xcc_id(); b.st = st;
    if (threadIdx.x == 0) (void)xb_add(&bar[XB_XCNT(b.x)], 1u);
    return b;
}
__device__ __forceinline__ void xcd_barrier_complete(unsigned* bar, unsigned x, unsigned& nloc, unsigned& nx) {
    const unsigned G = gridDim.x * gridDim.y * gridDim.z;
    unsigned sum, cnt, mine, sp = 0u;
    for (;;) {
        sum = 0u; cnt = 0u; mine = 0u;
#pragma unroll
        for (unsigned j = 0; j < 16; ++j) { const unsigned c = xb_ld(&bar[XB_XCNT(j)]); sum += c; cnt += (c > 0u) ? 1u : 0u; mine = (j == x) ? c : mine; }
        if (sum == G) break;
        __builtin_amdgcn_s_sleep(1);
        if ((++sp & 255u) == 0u) { if (xb_ld(&bar[XB_TMO])) break; if (sp > XB_SPIN_CAP) { atomicAdd(&bar[XB_TMO], 1u); break; } }
    }
    nloc = mine > 0u ? mine : 1u; nx = cnt > 0u ? cnt : 1u;
}
__device__ __forceinline__ void xcd_barrier(const XcdBarrier& b) {
    asm volatile("s_waitcnt vmcnt(0)" ::: "memory");
    __syncthreads();
    if (threadIdx.x == 0) {
        unsigned* bar = b.bar;
        __builtin_amdgcn_s_waitcnt(0);
        unsigned nloc = b.st[0], nx = b.st[1];
        if (nloc == 0u) { xcd_barrier_complete(bar, b.x, nloc, nx); b.st[0] = nloc; b.st[1] = nx; }
        const unsigned old = xb_add(&bar[XB_XSUB(b.x)], 1u);
        const unsigned gen = old / nloc;
        if (old + 1u == (gen + 1u) * nloc) {
            __builtin_amdgcn_fence(__ATOMIC_RELEASE, "agent");
            asm volatile("s_waitcnt vmcnt(0)" ::: "memory");
            const unsigned og = xb_add(&bar[XB_TOP], 1u);
            const unsigned tg = og / nx;
            if (og + 1u == (tg + 1u) * nx) xb_add(&bar[XB_TOPGEN], 1u);
            else XB_SPIN(xb_ld(&bar[XB_TOPGEN]) == tg, bar);
            __builtin_amdgcn_fence(__ATOMIC_ACQUIRE, "agent");
            xb_add(&bar[XB_XGEN(b.x)], 1u);
            asm volatile("s_waitcnt vmcnt(0)" ::: "memory");
        } else {
            XB_SPIN(xb_ld(&bar[XB_XGEN(b.x)]) == gen, bar);
            __builtin_amdgcn_fence(__ATOMIC_ACQUIRE, "agent");
            asm volatile("s_waitcnt vmcnt(0)" ::: "memory");
        }
    }
    __syncthreads();
}

struct Args { const float* in[24]; const int* page_table; float* out; unsigned char* ws; int ph_lo, ph_hi, li, pad; };
enum { I_XP = 0, I_XS, I_CK, I_CV, I_PT, I_REL, I_NF1, I_WGU1, I_WD1, I_NM, I_WIN, I_LQ1, I_LK1, I_LQ2, I_LK2, I_SUBLN, I_GNORM, I_WS, I_BS, I_WOUT, I_NF2, I_WGU2, I_WD2, I_NFIN };

struct Frame {
    LAS unsigned char* lds; volatile LAS unsigned* MISC; unsigned* ctl;
    int tid, lane, wave, vcu, G;
    unsigned char* ws; float* out;
};

struct TItem { const float* W; const float* gain; bf16_t* WT; int K, N, drow0, k0, n0; };
__device__ __forceinline__ int gu_drow(int n0) { return (n0 < DFF) ? ((n0 >> 7) * 256 + (n0 & 127)) : (((n0 - DFF) >> 7) * 256 + 128 + ((n0 - DFF) & 127)); }
__device__ __forceinline__ void p0_item_load(const TItem& t, int lane, f32x4 (&v)[8], float (&g)[8]) {
    const int rr = lane >> 3, c4 = 4 * (lane & 7);
#pragma unroll
    for (int i = 0; i < 8; ++i) { const int kk = 8 * i + rr; v[i] = *(const f32x4*)(t.W + (size_t)(t.k0 + kk) * t.N + t.n0 + c4); g[i] = t.gain ? t.gain[t.k0 + kk] : 1.f; }
}
__device__ __forceinline__ void p0_item_store(const TItem& t, int lane, const f32x4 (&v)[8], const float (&g)[8], LAS float* scr) {
    const int rr = lane >> 3, c4 = 4 * (lane & 7);
#pragma unroll
    for (int i = 0; i < 8; ++i) { const int kk = 8 * i + rr;
#pragma unroll
        for (int j = 0; j < 4; ++j) scr[kk * 33 + c4 + j] = v[i][j] * g[i]; }
    LDS_WAIT(); asm volatile("" ::: "memory");
    const int c = lane & 7;
#pragma unroll
    for (int j = 0; j < 4; ++j) { const int n = (lane >> 3) + 8 * j; const LAS float* s = scr + (8 * c) * 33 + n;
        u32x4 o; o.x = cvt_pk_bf16(s[0 * 33], s[1 * 33]); o.y = cvt_pk_bf16(s[2 * 33], s[3 * 33]); o.z = cvt_pk_bf16(s[4 * 33], s[5 * 33]); o.w = cvt_pk_bf16(s[6 * 33], s[7 * 33]);
        *(u32x4*)(t.WT + (size_t)(t.drow0 + n) * t.K + t.k0 + 8 * c) = o; }
    LDS_WAIT(); asm volatile("" ::: "memory");
}

__device__ __forceinline__ void p0_prologue(Frame& F, const Args& a) {
    LAS float* scr = (LAS float*)(F.lds + F.wave * 16384);
    const int gw = F.vcu * NWAVES + F.wave, NGW = F.G * NWAVES;
    constexpr int I_GU = (DM / 64) * (NGU / 32), I_DN = (DFF / 64) * (DM / 32), I_IN = (DM / 64) * (NIN / 32), I_OUT = (DM / 64) * (DM / 32);
    constexpr int NITEMS = 2 * I_GU + 2 * I_DN + I_IN + I_OUT;
    auto decode = [&](int it) -> TItem { int r = it; TItem t;
        if (r < I_GU) { const int nb = NGU / 32; t.k0 = 64 * (r / nb); t.n0 = 32 * (r % nb); t.W = a.in[I_WGU1]; t.gain = a.in[I_NF1]; t.WT = (bf16_t*)(F.ws + WS_WGU1); t.K = DM; t.N = NGU; t.drow0 = gu_drow(t.n0); return t; } r -= I_GU;
        if (r < I_GU) { const int nb = NGU / 32; t.k0 = 64 * (r / nb); t.n0 = 32 * (r % nb); t.W = a.in[I_WGU2]; t.gain = a.in[I_NF2]; t.WT = (bf16_t*)(F.ws + WS_WGU2); t.K = DM; t.N = NGU; t.drow0 = gu_drow(t.n0); return t; } r -= I_GU;
        if (r < I_DN) { const int nb = DM / 32; t.k0 = 64 * (r / nb); t.n0 = 32 * (r % nb); t.W = a.in[I_WD1]; t.gain = nullptr; t.WT = (bf16_t*)(F.ws + WS_WD1); t.K = DFF; t.N = DM; t.drow0 = t.n0; return t; } r -= I_DN;
        if (r < I_DN) { const int nb = DM / 32; t.k0 = 64 * (r / nb); t.n0 = 32 * (r % nb); t.W = a.in[I_WD2]; t.gain = nullptr; t.WT = (bf16_t*)(F.ws + WS_WD2); t.K = DFF; t.N = DM; t.drow0 = t.n0; return t; } r -= I_DN;
        if (r < I_IN) { const int nb = NIN / 32; t.k0 = 64 * (r / nb); t.n0 = 32 * (r % nb); t.W = a.in[I_WIN]; t.gain = a.in[I_NM]; t.WT = (bf16_t*)(F.ws + WS_WIN); t.K = DM; t.N = NIN; t.drow0 = t.n0; return t; } r -= I_IN;
        { const int nb = DM / 32; t.k0 = 64 * (r / nb); t.n0 = 32 * (r % nb); t.W = a.in[I_WOUT]; t.gain = nullptr; t.WT = (bf16_t*)(F.ws + WS_WOUT); t.K = DM; t.N = DM; t.drow0 = t.n0; return t; } };
    if (gw < NITEMS) {
        const int nmine = (NITEMS - gw + NGW - 1) / NGW, last = gw + (nmine - 1) * NGW;
        TItem cur = decode(gw); f32x4 vc[8]; float gc[8]; p0_item_load(cur, F.lane, vc, gc);
#pragma unroll 1
        for (int i = 0; i < nmine; ++i) {
            const int nit = (gw + (i + 1) * NGW <= last) ? gw + (i + 1) * NGW : last;
            const TItem nxt = decode(nit); f32x4 vn[8]; float gn[8]; p0_item_load(nxt, F.lane, vn, gn);
            p0_item_store(cur, F.lane, vc, gc, scr);
            cur = nxt;
#pragma unroll
            for (int j = 0; j < 8; ++j) { vc[j] = vn[j]; gc[j] = gn[j]; }
        }
    }
    bf16_t* XB = (bf16_t*)(F.ws + WS_XB); float* SSQ = (float*)(F.ws + WS_SSQ);
    { const int npair = (MT - gw + 2 * NGW - 1) / (2 * NGW);
      auto rowp = [&](int m) -> const f32x4* { return (const f32x4*)((m < MP) ? a.in[I_XP] + (size_t)m * DM : a.in[I_XS] + (size_t)(m - MP) * DM) + F.lane; };
      f32x4 c0[4], c1[4]; int m0 = gw, m1 = (gw + NGW < MT) ? gw + NGW : gw;
      { const f32x4* p0 = rowp(m0); const f32x4* p1 = rowp(m1);
#pragma unroll
        for (int j = 0; j < 4; ++j) { c0[j] = p0[64 * j]; c1[j] = p1[64 * j]; } }
#pragma unroll 1
      for (int i = 0; i < npair; ++i) {
          int n0 = m0 + 2 * NGW, n1 = m0 + 3 * NGW; if (n0 >= MT) n0 = m0; if (n1 >= MT) n1 = n0;
          f32x4 d0[4], d1[4]; { const f32x4* p0 = rowp(n0); const f32x4* p1 = rowp(n1);
#pragma unroll
            for (int j = 0; j < 4; ++j) { d0[j] = p0[64 * j]; d1[j] = p1[64 * j]; } }
          float s0 = 0.f, s1 = 0.f;
#pragma unroll
          for (int j = 0; j < 4; ++j) { s0 += (c0[j].x * c0[j].x + c0[j].y * c0[j].y) + (c0[j].z * c0[j].z + c0[j].w * c0[j].w); s1 += (c1[j].x * c1[j].x + c1[j].y * c1[j].y) + (c1[j].z * c1[j].z + c1[j].w * c1[j].w); }
#pragma unroll
          for (int o = 1; o < 64; o <<= 1) { s0 += __shfl_xor(s0, o); s1 += __shfl_xor(s1, o); }
          u32x2* o0 = (u32x2*)(XB + (size_t)m0 * DM) + F.lane; u32x2* o1 = (u32x2*)(XB + (size_t)m1 * DM) + F.lane;
#pragma unroll
          for (int j = 0; j < 4; ++j) { u32x2 w; w.x = cvt_pk_bf16(c0[j].x, c0[j].y); w.y = cvt_pk_bf16(c0[j].z, c0[j].w); o0[64 * j] = w;
                                        u32x2 w1; w1.x = cvt_pk_bf16(c1[j].x, c1[j].y); w1.y = cvt_pk_bf16(c1[j].z, c1[j].w); o1[64 * j] = w1; }
          if (F.lane < 16) { SSQ[(size_t)m0 * 16 + F.lane] = (F.lane == 0) ? s0 : 0.f; SSQ[(size_t)m1 * 16 + F.lane] = (F.lane == 0) ? s1 : 0.f; }
          m0 = n0; m1 = n1;
#pragma unroll
          for (int j = 0; j < 4; ++j) { c0[j] = d0[j]; c1[j] = d1[j]; }
      } }
    const int gt = F.vcu * 512 + F.tid, NGT = F.G * 512;
    bf16_t* WT = (bf16_t*)(F.ws + WS_WTRIL);
    for (int e = gt; e < 4 * 128 * 128; e += NGT) { const int i = (e >> 7) & 127, j = e & 127; const float w = (j <= i) ? a.in[I_WS][e] : 0.f; WT[e] = (bf16_t)(cvt_pk_bf16(w, 0.f) & 0xffffu); }
    float* BT = (float*)(F.ws + WS_BTAB);
    for (int e = gt; e < 8 * 128; e += NGT) { const int m = e >> 7, d = e & 127; int bk;
        if (d < 16) bk = d; else { bk = 16 + (int)(__logf((float)d * (1.f / 16.f)) / 2.0794415416798357f * 16.f); if (bk > 31) bk = 31; }
        BT[e] = a.in[I_REL][bk * 8 + m] * LOG2E; }
}

template <class Sched> __device__ __forceinline__ void rstab_fill(Frame& F, const Sched& S) {
    LAS float* rstab = (LAS float*)(F.lds + RSTAB_OFF); const float* SSQ = (const float*)(F.ws + WS_SSQ);
    pg8::Unit u;
    for (int i = 0; i < 6 && S.next(i, u); ++i) {
        if ((i & 1) == (F.tid >> 8)) { const int r = F.tid & 255; const f32x4* p = (const f32x4*)(SSQ + (size_t)(u.pm * 256 + r) * 16);
            const f32x4 a = p[0], b = p[1], c = p[2], d = p[3]; const f32x4 s = (a + b) + (c + d);
            rstab[i * 256 + r] = __builtin_amdgcn_rsqf(((s[0] + s[1]) + (s[2] + s[3])) * (1.f / DM) + EPS); }
    }
    __syncthreads();
}

template <int MODE> __device__ __forceinline__ void mini_gemm_resid(Frame& F, const bf16_t* A, const bf16_t* Bt, int K, const float* xold, int xoff, float* xnew, bf16_t* xb, float alpha) {
    LAS float* red = (LAS float*)F.lds;
    LAS float* ssr = (LAS float*)(F.lds + 32768);
    float* SSQ = (float*)(F.ws + WS_SSQ);
    const int fr = F.lane & 15, fq = F.lane >> 4, kw = K / 8;
    for (int t = F.vcu; t < 256; t += F.G) {
        const int rb = t >> 4, cb = t & 15;
        f32x4 acc[4];
#pragma unroll
        for (int n = 0; n < 4; ++n) acc[n] = (f32x4){0.f, 0.f, 0.f, 0.f};
        const bf16_t* ap = A + (size_t)(MP + 16 * rb + fr) * K + F.wave * kw + 8 * fq;
        const bf16_t* bp = Bt + (size_t)(64 * cb + fr) * K + F.wave * kw + 8 * fq;
        for (int s = 0; s < kw; s += 32) {
            const bf16x8 af = *(const bf16x8*)(ap + s);
#pragma unroll
            for (int n = 0; n < 4; ++n) { const bf16x8 bf = *(const bf16x8*)(bp + (size_t)16 * n * K + s); acc[n] = __builtin_amdgcn_mfma_f32_16x16x32_bf16(bf, af, acc[n], 0, 0, 0); }
        }
#pragma unroll
        for (int n = 0; n < 4; ++n) *(LAS f32x4*)(red + (F.wave * 64 + F.lane) * 16 + n * 4) = acc[n];
        __syncthreads();
        const int e = 2 * F.wave;
        f32x2 sum = (f32x2){0.f, 0.f};
#pragma unroll
        for (int w = 0; w < 8; ++w) { const f32x2 p = *(const LAS f32x2*)(red + (w * 64 + F.lane) * 16 + e); sum += p; }
        const int row = MP + 16 * rb + fr, col = 64 * cb + 16 * (e >> 2) + 4 * fq + (e & 3);
        const size_t off = (size_t)row * DM + col;
        f32x2 xo;
        if (MODE == 0) xo = *(const f32x2*)(xold + off - (size_t)xoff * DM);
        else { const unsigned w = *(const unsigned*)(xb + off); xo = (f32x2){__uint_as_float(w << 16), __uint_as_float(w & 0xffff0000u)}; }
        const f32x2 xn = xo + sum * alpha;
        if (MODE == 2) *(f32x2*)(xnew + off) = xn; else *(unsigned*)(xb + off) = cvt_pk_bf16(xn[0], xn[1]);
        float ss = xn[0] * xn[0] + xn[1] * xn[1]; ss += __shfl_xor(ss, 16); ss += __shfl_xor(ss, 32);
        if (fq == 0) ssr[F.wave * 16 + fr] = ss;
        __syncthreads();
        if (F.tid < 16) { float s = 0.f;
#pragma unroll
            for (int w = 0; w < 8; ++w) s += ssr[w * 16 + F.tid];
            SSQ[(size_t)(MP + 16 * rb + F.tid) * 16 + cb] = s; }
        __syncthreads();
    }
}

namespace att {
typedef LAS const char* lds_cptr;
typedef short v4i16_t __attribute__((ext_vector_type(4)));
__device__ __forceinline__ int crow(int r, int hi) { return (r & 3) + 8 * (r >> 2) + 4 * hi; }
__device__ __forceinline__ void glds16(const void* gsrc, unsigned lds_dst) { unsigned keep;
    asm volatile("s_mov_b32 %0, m0\n\ts_mov_b32 m0, %2\n\ts_nop 0\n\tglobal_load_lds_dwordx4 %1, off\n\ts_mov_b32 m0, %0" : "=&s"(keep) : "v"(gsrc), "s"(lds_dst) : "memory"); }
__device__ __forceinline__ s16x4 vtr(lds_cptr p) { return __builtin_bit_cast(s16x4, __builtin_amdgcn_ds_read_tr16_b64_v4i16((LAS v4i16_t*)p)); }
#define MX3(a, b, c) __builtin_fmaxf(__builtin_fmaxf((a), (b)), (c))
__device__ __forceinline__ float rowmax32(const f32x16& p0, const f32x16& p1) {
    float a = MX3(p0[0], p0[1], p1[0]), b = MX3(p0[2], p0[3], p1[1]); a = MX3(a, p1[2], p1[3]);
#pragma unroll
    for (int r = 4; r < 16; r += 4) { a = MX3(a, p0[r], p0[r + 1]); b = MX3(b, p0[r + 2], p0[r + 3]); a = MX3(a, p1[r], p1[r + 1]); b = MX3(b, p1[r + 2], p1[r + 3]); }
    const float m = __builtin_fmaxf(a, b);
    return __builtin_fmaxf(m, __shfl_xor(m, 32));
}
#define WAIT_BAR(N) asm volatile("s_waitcnt vmcnt(" #N ") lgkmcnt(0)\n\ts_barrier" ::: "memory")
constexpr int BUFB = 32768, NBUF = 4;
constexpr int L_WSF = RING_BYTES + 512, L_LINV = L_WSF + 2048, L_BTAB = L_LINV + 1024;
static_assert(L_BTAB + 4096 <= LDS_BYTES, "attention LDS map");
constexpr float THR = 6.0f;

__device__ __forceinline__ void attn_unit(int b, int h, int qb, const bf16_t* Qb, const bf16_t* Kb, const bf16_t* Vb, bf16_t* MIX, const float* subln, float lam, LAS unsigned char* lds) {
    const int tid = threadIdx.x, lane = tid & 63, r32 = lane & 31, hi = lane >> 5; const int wid = __builtin_amdgcn_readfirstlane(tid >> 6);
    const int mi = wid >> 2, sub = wid & 3;
    const int q0 = qb * 128, qw = q0 + 32 * sub, NT = (q0 + 128) / 64;
    const size_t rowbase = (size_t)b * SEQ;
    const unsigned lds0 = (unsigned)(uintptr_t)lds;
    const bf16_t* ksrc0 = Kb + (rowbase + lane) * AW + (2 * h) * 64 + wid * 8;
    const bf16_t* ksrc1 = ksrc0 + 64;
    const bf16_t* vsrc0 = Vb + (rowbase + 16 * (wid & 3) + (lane >> 2)) * AW + h * 128 + (wid >> 2) * 32 + (lane & 3) * 8;
    const bf16_t* vsrc1 = vsrc0 + 64;
#define DMA_TILE(t, boff) do { const size_t go_ = (size_t)(t) * 64 * AW; const unsigned bo_ = lds0 + (boff) + wid * 1024; \
        glds16(ksrc0 + go_, (unsigned)__builtin_amdgcn_readfirstlane(bo_)); glds16(ksrc1 + go_, (unsigned)__builtin_amdgcn_readfirstlane(bo_ + 8192)); \
        glds16(vsrc0 + go_, (unsigned)__builtin_amdgcn_readfirstlane(bo_ + 16384)); glds16(vsrc1 + go_, (unsigned)__builtin_amdgcn_readfirstlane(bo_ + 16384 + 8192)); } while (0)
    DMA_TILE(0, 0); DMA_TILE(1, BUFB); if (NT > 2) DMA_TILE(2, 2 * BUFB);
    bf16x8 qr[4];
    { const bf16_t* Qw = Qb + (rowbase + qw + r32) * AW + (2 * h + mi) * 64 + hi * 8;
#pragma unroll
      for (int d0 = 0; d0 < 4; ++d0) qr[d0] = *(const bf16x8*)(Qw + d0 * 16); }
    LAS float* wsf = (LAS float*)(lds + L_WSF) + wid * 64;
    const LAS float* bt = (const LAS float*)(lds + L_BTAB) + (2 * h + mi) * 128;
    const float b31 = bt[127];
    float mhat = -INFINITY, l_reg = 0.f;
    f32x16 o[4];
#pragma unroll
    for (int d = 0; d < 4; ++d) o[d] = f32x16{};
    const lds_cptr kp0 = (lds_cptr)lds + mi * 8192 + hi * 1024 + r32 * 16;
    const lds_cptr vp0 = (lds_cptr)lds + 16384 + ((lane >> 4) & 1) * 32 + (lane & 3) * 8 + (4 * hi + ((lane & 15) >> 2)) * 64;
#define QK_TILE(P0, P1, boff) do { P0 = f32x16{}; P1 = f32x16{}; \
        _Pragma("unroll") for (int d0 = 0; d0 < 4; ++d0) { \
            const bf16x8 k0f_ = *(const LAS bf16x8*)(kp0 + (boff) + d0 * 2048), k1f_ = *(const LAS bf16x8*)(kp0 + (boff) + d0 * 2048 + 512); \
            P0 = __builtin_amdgcn_mfma_f32_32x32x16_bf16(k0f_, qr[d0], P0, 0, 0, 0); P1 = __builtin_amdgcn_mfma_f32_32x32x16_bf16(k1f_, qr[d0], P1, 0, 0, 0); } } while (0)
#define SM_PV(P0, P1, N0, N1, t_, boff, nboff) do { const int k0_ = 64 * (t_); \
        float cadd = b31; \
        if (k0_ + 63 > qw - 113) { cadd = 0.f; const int dq = qw + r32 - k0_ - 4 * hi; \
            _Pragma("unroll") for (int r = 0; r < 16; ++r) { const int d0_ = dq - ((r & 3) + 8 * (r >> 2)), d1_ = d0_ - 32; \
                P0[r] = (d0_ < 0) ? -INFINITY : P0[r] + bt[d0_ > 127 ? 127 : d0_]; \
                P1[r] = (d1_ < 0) ? -INFINITY : P1[r] + bt[d1_ > 127 ? 127 : d1_]; } } \
        const float rm = rowmax32(P0, P1) + cadd; \
        if (__any(rm > mhat + THR)) { \
            const float mnew = __builtin_fmaxf(mhat, rm); const float f = __builtin_amdgcn_exp2f(mhat - mnew); mhat = mnew; l_reg *= f; \
            if (hi == 0) wsf[r32] = f; \
            LDS_WAIT(); \
            _Pragma("unroll") for (int r = 0; r < 16; ++r) { const float fr_ = wsf[crow(r, hi)]; \
                _Pragma("unroll") for (int d = 0; d < 4; ++d) o[d][r] *= fr_; } } \
        const float nm = cadd - mhat; float sacc = 0.f; \
        QK_TILE(N0, N1, nboff);     \
        _Pragma("unroll") for (int r = 0; r < 16; ++r) { P0[r] = __builtin_amdgcn_exp2f(P0[r] + nm); P1[r] = __builtin_amdgcn_exp2f(P1[r] + nm); sacc += P0[r] + P1[r]; } \
        l_reg += sacc; \
        u32x4 pw[4]; \
        _Pragma("unroll") for (int j = 0; j < 4; ++j) { pw[0][j] = cvt_pk_bf16(P0[2 * j], P0[2 * j + 1]); pw[1][j] = cvt_pk_bf16(P0[8 + 2 * j], P0[8 + 2 * j + 1]); \
                                                      pw[2][j] = cvt_pk_bf16(P1[2 * j], P1[2 * j + 1]); pw[3][j] = cvt_pk_bf16(P1[8 + 2 * j], P1[8 + 2 * j + 1]); } \
        _Pragma("unroll") for (int ks = 0; ks < 4; ++ks) _Pragma("unroll") for (int d = 0; d < 4; ++d) { \
            const s16x4 lo = vtr(vp0 + (boff) + d * 4096 + ks * 1024), hh = vtr(vp0 + (boff) + d * 4096 + ks * 1024 + 512); \
            const bf16x8 vf = (bf16x8){lo[0], lo[1], lo[2], lo[3], hh[0], hh[1], hh[2], hh[3]}; \
            o[d] = __builtin_amdgcn_mfma_f32_32x32x16_bf16(__builtin_bit_cast(bf16x8, pw[ks]), vf, o[d], 0, 0, 0); } } while (0)
#define STEP(PC0, PC1, PN0, PN1, t_) do { const int tt_ = (t_); \
        if (tt_ + 2 < NT) WAIT_BAR(4); else WAIT_BAR(0); \
        if (tt_ + 3 < NT) DMA_TILE(tt_ + 3, ((tt_ + 3) & 3) * BUFB); \
        SM_PV(PC0, PC1, PN0, PN1, tt_, (tt_ & 3) * BUFB, ((tt_ + 1) & 3) * BUFB); } while (0)
    f32x16 pA0, pA1, pB0, pB1;
    if (NT > 2) WAIT_BAR(8); else WAIT_BAR(4);
    QK_TILE(pA0, pA1, 0);
#pragma unroll 1
    for (int t = 0; t < NT; t += 2) {
        STEP(pA0, pA1, pB0, pB1, t);
        STEP(pB0, pB1, pA0, pA1, t + 1);
    }
#undef STEP
#undef SM_PV
#undef QK_TILE
    l_reg += __shfl_xor(l_reg, 32);
    WAIT_BAR(0);
    int hiF = hi, r32F = r32; asm volatile("" : "+v"(hiF), "+v"(r32F));
    LAS float* linv = (LAS float*)(lds + L_LINV);
    if (hiF == 0) linv[(mi * 4 + sub) * 32 + r32F] = l_reg;
    LAS float* stg = (LAS float*)lds + sub * 4096 + hiF * 512 + r32F;
    if (mi == 1) {
#pragma unroll
        for (int r = 0; r < 16; ++r)
#pragma unroll
            for (int d = 0; d < 4; ++d) stg[crow(r, 0) * 128 + d * 32] = o[d][r];
    }
    WAIT_BAR(0);
    if (mi == 0) {
        float sg[4];
#pragma unroll
        for (int d = 0; d < 4; ++d) sg[d] = subln[d * 32 + r32F] * (1.f - LAM_INIT);
        bf16_t* dst = MIX + (rowbase + qw + 4 * hiF) * DM + h * 128 + r32F;
        const LAS float* lv = linv + sub * 32 + 4 * hiF;
#pragma unroll
        for (int r = 0; r < 16; ++r) { const int row = crow(r, 0);
            const float a = __builtin_amdgcn_rcpf(lv[row]), bq = lam * __builtin_amdgcn_rcpf(lv[128 + row]);
            float v[4]; float ss = 0.f;
#pragma unroll
            for (int d = 0; d < 4; ++d) { v[d] = o[d][r] * a - bq * stg[row * 128 + d * 32]; ss += v[d] * v[d]; }
            ss += __shfl_xor(ss, 1); ss += __shfl_xor(ss, 2); ss += __shfl_xor(ss, 4); ss += __shfl_xor(ss, 8); ss += __shfl_xor(ss, 16);
            const float sc = __builtin_amdgcn_rsqf(ss * (1.f / 128.f) + EPS);
#pragma unroll
            for (int d = 0; d < 4; ++d) dst[(size_t)row * DM + d * 32] = (bf16_t)(cvt_pk_bf16(v[d] * sc * sg[d], 0.f) & 0xffffu);
        }
    }
    WAIT_BAR(0);
#undef DMA_TILE
}

__device__ __forceinline__ void spatial_unit(int c, int g, const bf16_t* GVb, const bf16_t* Ub, const bf16_t* WT, const float* bs, bf16_t* MIX, LAS unsigned char* lds) {
    const int tid = threadIdx.x, lane = tid & 63, r32 = lane & 31, hi = lane >> 5; const int wid = __builtin_amdgcn_readfirstlane(tid >> 6);
    const int ib = wid & 3, chh = wid >> 2;
    const unsigned lds0 = (unsigned)(uintptr_t)lds;
    const size_t row0 = (size_t)c * 128;
    VM_WAIT();
#pragma unroll
    for (int j = 0; j < 4; ++j) { const int p = wid + 8 * j, jt = p >> 4, db = (p >> 2) & 3, kg = p & 3;
        const bf16_t* src = GVb + (row0 + 64 * jt + 16 * kg + (lane >> 2)) * AW + g * 128 + db * 32 + (lane & 3) * 8;
        glds16(src, (unsigned)__builtin_amdgcn_readfirstlane(lds0 + jt * 16384 + (db * 4 + kg) * 1024)); }
    f32x16 o[2]; o[0] = f32x16{}; o[1] = f32x16{};
    const bf16_t* wrow = WT + ((size_t)g * 128 + 32 * ib + r32) * 128 + 4 * hi;
    WAIT_BAR(0);
    const lds_cptr vp0 = (lds_cptr)lds + ((lane >> 4) & 1) * 32 + (lane & 3) * 8 + (4 * hi + ((lane & 15) >> 2)) * 64;
#pragma unroll 1
    for (int ks = 0; ks < 2 * ib + 2; ++ks) {
        const u32x2 a0 = *(const u32x2*)(wrow + 16 * ks), a1 = *(const u32x2*)(wrow + 16 * ks + 8);
        const u32x4 aw = (u32x4){a0.x, a0.y, a1.x, a1.y};
        const int jt = ks >> 2, kk = ks & 3;
#pragma unroll
        for (int d = 0; d < 2; ++d) { const int db = 2 * chh + d;
            const s16x4 lo = vtr(vp0 + jt * 16384 + db * 4096 + kk * 1024), hh = vtr(vp0 + jt * 16384 + db * 4096 + kk * 1024 + 512);
            const bf16x8 vf = (bf16x8){lo[0], lo[1], lo[2], lo[3], hh[0], hh[1], hh[2], hh[3]};
            o[d] = __builtin_amdgcn_mfma_f32_32x32x16_bf16(__builtin_bit_cast(bf16x8, aw), vf, o[d], 0, 0, 0); }
    }
    int hiF = hi, r32F = r32; asm volatile("" : "+v"(hiF), "+v"(r32F));
#pragma unroll
    for (int r = 0; r < 16; ++r) { const int i = 32 * ib + crow(r, 0) + 4 * hiF; const float bi = bs[g * 128 + i];
#pragma unroll
        for (int d = 0; d < 2; ++d) { const int ch = g * 128 + (2 * chh + d) * 32 + r32F;
            const float uu = bf2f(Ub[(row0 + i) * AW + ch]);
            MIX[(row0 + i) * DM + 512 + ch] = (bf16_t)(cvt_pk_bf16(uu * (o[d][r] + bi), 0.f) & 0xffffu); } }
    WAIT_BAR(0);
}

__device__ __forceinline__ void sample_unit(int b, int h, const float* ck, const float* cv, const int* pt, const bf16_t* Qb, const bf16_t* Kb, const bf16_t* Vb, const bf16_t* Ub,
                                            const float* gs, const float* wsp, const float* bsp, bf16_t* MIX, const float* subln, float lam, LAS unsigned char* lds) {
    int tid = threadIdx.x; const int wid = __builtin_amdgcn_readfirstlane(tid >> 6);
    asm volatile("" : "+v"(tid));
    const int lane = tid & 63, fr = lane & 15, fq = lane >> 4;
    LAS float* P = (LAS float*)(lds + wid * 4096);
    LAS float* Fv = P + 512;
    const LAS float* btl = (const LAS float*)(lds + L_BTAB);
    LAS float* part = (LAS float*)(lds + 32768);
    bf16x8 qf[2][2];
#pragma unroll
    for (int mi = 0; mi < 2; ++mi)
#pragma unroll
        for (int kk = 0; kk < 2; ++kk) { bf16x8 z = (bf16x8){0, 0, 0, 0, 0, 0, 0, 0};
            if (fr < 8) z = *(const bf16x8*)(Qb + (size_t)(MP + b * 8 + fr) * AW + (2 * h + mi) * 64 + 32 * kk + 8 * fq);
            qf[mi][kk] = z; }
    float m[2] = {-INFINITY, -INFINITY}, ls[2] = {0.f, 0.f};
    f32x2 o[16];
#pragma unroll
    for (int i = 0; i < 16; ++i) o[i] = (f32x2){0.f, 0.f};
    LAS int* pids = (LAS int*)(P + 640);
    if (lane < 8) pids[lane] = pt[b * NPAGES + wid * 8 + lane];
    LDS_WAIT(); asm volatile("" ::: "memory");
    f32x4 kr[2][2][2][2];
    const __amdgpu_buffer_rsrc_t rk = __builtin_amdgcn_make_buffer_rsrc((void*)ck, 0, 0x7fffffff, 0x00020000), rv = __builtin_amdgcn_make_buffer_rsrc((void*)cv, 0, 0x7fffffff, 0x00020000);
    const int kvoff = fr * (AW * 4) + fq * 32, vvoff = lane * 8;
#define LOAD_K(nb_) do { const int pid_ = __builtin_amdgcn_readfirstlane(pids[(nb_) >> 2]); const int kro_ = (pid_ * PAGE + ((nb_) & 3) * 32) * (AW * 4) + (2 * h) * 256; \
        _Pragma("unroll") for (int kb = 0; kb < 2; ++kb) _Pragma("unroll") for (int mi = 0; mi < 2; ++mi) _Pragma("unroll") for (int kk = 0; kk < 2; ++kk) { \
            const int so_ = kro_ + kb * 16 * (AW * 4) + mi * 256 + kk * 128; \
            kr[kb][mi][kk][0] = __builtin_bit_cast(f32x4, __builtin_amdgcn_raw_buffer_load_b128(rk, kvoff, so_, 2)); kr[kb][mi][kk][1] = __builtin_bit_cast(f32x4, __builtin_amdgcn_raw_buffer_load_b128(rk, kvoff + 16, so_, 2)); } } while (0)
    LOAD_K(0);
    f32x2 va[16], vb[16];
#define LOAD_V(dst, nb_, half_) do { const int pid_ = __builtin_amdgcn_readfirstlane(pids[(nb_) >> 2]); const int vro_ = (pid_ * PAGE + ((nb_) & 3) * 32 + 16 * (half_)) * (AW * 4) + h * 512; \
        _Pragma("unroll") for (int k = 0; k < 16; ++k) dst[k] = __builtin_bit_cast(f32x2, __builtin_amdgcn_raw_buffer_load_b64(rv, vvoff, vro_ + k * (AW * 4), 2)); } while (0)
#define PV_HALF(src, half_) do { _Pragma("unroll") for (int k = 0; k < 16; ++k) { const LAS f32x4* pp = (const LAS f32x4*)(P + (16 * (half_) + k) * 16); const f32x4 p0 = pp[0], p1 = pp[1], p2 = pp[2], p3 = pp[3]; \
        _Pragma("unroll") for (int j = 0; j < 4; ++j) { o[j] += src[k] * p0[j]; o[4 + j] += src[k] * p1[j]; o[8 + j] += src[k] * p2[j]; o[12 + j] += src[k] * p3[j]; } \
        if (k & 1) __builtin_amdgcn_sched_barrier(0); } } while (0)
    LOAD_V(va, 0, 0);
#pragma unroll 1
    for (int nb = 0; nb < 32; ++nb) {
        const int kpos0 = (wid * 8 + (nb >> 2)) * PAGE + (nb & 3) * 32;
        f32x4 s[2][2];
#pragma unroll
        for (int kb = 0; kb < 2; ++kb)
#pragma unroll
            for (int mi = 0; mi < 2; ++mi) { f32x4 a = (f32x4){0.f, 0.f, 0.f, 0.f};
#pragma unroll
                for (int kk = 0; kk < 2; ++kk) { const f32x4 x = kr[kb][mi][kk][0], y = kr[kb][mi][kk][1];
                    u32x4 w; w.x = cvt_pk_bf16(x[0], x[1]); w.y = cvt_pk_bf16(x[2], x[3]); w.z = cvt_pk_bf16(y[0], y[1]); w.w = cvt_pk_bf16(y[2], y[3]);
                    a = __builtin_amdgcn_mfma_f32_16x16x32_bf16(__builtin_bit_cast(bf16x8, w), qf[mi][kk], a, 0, 0, 0); }
                s[kb][mi] = a; }
        const int nbn = (nb + 1 < 32) ? nb + 1 : 31;
        LOAD_K(nbn);
        LOAD_V(vb, nb, 1);
#pragma unroll
        for (int mi = 0; mi < 2; ++mi) { const LAS float* bt = btl + (2 * h + mi) * 128;
            if (kpos0 > 8048) {
#pragma unroll
                for (int kb = 0; kb < 2; ++kb)
#pragma unroll
                    for (int j = 0; j < 4; ++j) { int d = SEQ + fr - (kpos0 + 16 * kb + 4 * fq + j); d = d > 127 ? 127 : d; s[kb][mi][j] += bt[d]; }
            } else { const float b31 = bt[127]; s[0][mi] += b31; s[1][mi] += b31; }
        }
#pragma unroll
        for (int mi = 0; mi < 2; ++mi) {
            float bm = __builtin_fmaxf(MX3(s[0][mi][0], s[0][mi][1], s[0][mi][2]), MX3(s[0][mi][3], s[1][mi][0], s[1][mi][1])); bm = MX3(bm, s[1][mi][2], s[1][mi][3]);
            bm = __builtin_fmaxf(bm, __shfl_xor(bm, 16)); bm = __builtin_fmaxf(bm, __shfl_xor(bm, 32));
            const float mnew = __builtin_fmaxf(m[mi], bm); const float fsc = __builtin_amdgcn_exp2f(m[mi] - mnew); m[mi] = mnew; ls[mi] *= fsc;
#pragma unroll
            for (int kb = 0; kb < 2; ++kb)
#pragma unroll
                for (int j = 0; j < 4; ++j) { const float p = __builtin_amdgcn_exp2f(s[kb][mi][j] - mnew); ls[mi] += p; if (fr < 8) P[(16 * kb + 4 * fq + j) * 16 + mi * 8 + fr] = p; }
            if (fr < 8 && fq == 0) Fv[mi * 8 + fr] = fsc;
        }
        LDS_WAIT(); asm volatile("" ::: "memory");
        { const LAS f32x4* fp = (const LAS f32x4*)Fv; const f32x4 f0 = fp[0], f1 = fp[1], f2 = fp[2], f3 = fp[3];
#pragma unroll
          for (int j = 0; j < 4; ++j) { o[j] *= f0[j]; o[4 + j] *= f1[j]; o[8 + j] *= f2[j]; o[12 + j] *= f3[j]; } }
        PV_HALF(va, 0);
        asm volatile("" ::: "memory");
        LOAD_V(va, nbn, 0);
        PV_HALF(vb, 1);
        LDS_WAIT(); asm volatile("" ::: "memory");
    }
#undef LOAD_V
#undef PV_HALF
#undef LOAD_K
#pragma unroll
    for (int mi = 0; mi < 2; ++mi) { float l = ls[mi]; l += __shfl_xor(l, 16); l += __shfl_xor(l, 32);
        if (fr < 8 && fq == 0) { part[wid * SPART_F + mi * 8 + fr] = m[mi]; part[wid * SPART_F + 16 + mi * 8 + fr] = l; } }
#pragma unroll
    for (int i = 0; i < 16; ++i) *(LAS f32x2*)(part + wid * SPART_F + 32 + i * 128 + 2 * lane) = o[i];
    __syncthreads();
    int tidF = tid; asm volatile("" : "+v"(tidF));
    LAS float* tot = (LAS float*)lds;
    { const int d = tidF & 127, qg = tidF >> 7;
#pragma unroll
      for (int e = 0; e < 4; ++e) { const int qm = qg * 4 + e; float mx = -INFINITY;
#pragma unroll
          for (int w = 0; w < 8; ++w) mx = __builtin_fmaxf(mx, part[w * SPART_F + qm]);
          float a = 0.f, l = 0.f;
#pragma unroll
          for (int w = 0; w < 8; ++w) { const float f = __builtin_amdgcn_exp2f(part[w * SPART_F + qm] - mx); a += f * part[w * SPART_F + 32 + qm * 128 + d]; l += f * part[w * SPART_F + 16 + qm]; }
          tot[32 + qm * 128 + d] = a; if (d == 0) { tot[qm] = mx; tot[16 + qm] = l; } } }
    LAS float* SN = (LAS float*)(lds + 16384);
    LAS float* W0 = SN + 128, *LI = W0 + 16, *PJ = LI + 16;
    if (tidF < 128) { const int mi = tidF >> 6, q = (tidF >> 3) & 7, j = tidF & 7; float sv = -INFINITY;
        if (j <= q) { const bf16_t* qp = Qb + (size_t)(MP + b * 8 + q) * AW + (2 * h + mi) * 64; const bf16_t* kp = Kb + (size_t)(MP + b * 8 + j) * AW + (2 * h + mi) * 64; float a = 0.f;
            for (int d = 0; d < 64; ++d) a += bf2f(qp[d]) * bf2f(kp[d]);
            sv = a + btl[(2 * h + mi) * 128 + (q - j)]; }
        SN[(mi * 8 + q) * 8 + j] = sv; }
    __syncthreads();
    if (tidF < 16) { const int qm = tidF; float mx = tot[qm];
        for (int j = 0; j < 8; ++j) mx = __builtin_fmaxf(mx, SN[qm * 8 + j]);
        const float w0 = __builtin_amdgcn_exp2f(tot[qm] - mx); float l = w0 * tot[16 + qm];
        for (int j = 0; j < 8; ++j) { const float p = __builtin_amdgcn_exp2f(SN[qm * 8 + j] - mx); PJ[qm * 8 + j] = p; l += p; }
        W0[qm] = w0; LI[qm] = 1.f / l; }
    __syncthreads();
    { const int q = tidF >> 6, d = 2 * (tidF & 63); float v[2];
#pragma unroll
      for (int e = 0; e < 2; ++e) { float om[2];
#pragma unroll
          for (int mi = 0; mi < 2; ++mi) { const int qm = mi * 8 + q; float a = W0[qm] * tot[32 + qm * 128 + d + e];
              for (int j = 0; j <= q; ++j) a += PJ[qm * 8 + j] * bf2f(Vb[(size_t)(MP + b * 8 + j) * AW + h * 128 + d + e]);
              om[mi] = a * LI[qm]; }
          v[e] = om[0] - lam * om[1]; }
      const float ss = wave_sum(v[0] * v[0] + v[1] * v[1]); const float sc = __builtin_amdgcn_rsqf(ss * (1.f / 128.f) + EPS) * (1.f - LAM_INIT);
      *(unsigned*)(MIX + (size_t)(MP + b * 8 + q) * DM + h * 128 + d) = cvt_pk_bf16(v[0] * sc * subln[d], v[1] * sc * subln[d + 1]); }
#pragma unroll
    for (int e2 = 0; e2 < 2; ++e2) { const int e = tidF + 512 * e2, i = e >> 7, ch = h * 128 + (e & 127); float a = bsp[h * 128 + i];
        for (int j = 0; j <= i; ++j) a += wsp[(h * 128 + i) * 128 + j] * gs[(size_t)(b * 8 + j) * AW + ch];
        const float uu = bf2f(Ub[(size_t)(MP + b * 8 + i) * AW + ch]);
        MIX[(size_t)(MP + b * 8 + i) * DM + 512 + ch] = (bf16_t)(cvt_pk_bf16(uu * a, 0.f) & 0xffffu); }
    __syncthreads();
}
#undef MX3
#undef WAIT_BAR
}

__global__ void __launch_bounds__(NWAVES * 64, 2) mega_fwd(Args args) {
    extern __shared__ __attribute__((aligned(16))) unsigned char lds_raw[];
    Frame F;
    F.lds = (LAS unsigned char*)lds_raw;
    F.MISC = (volatile LAS unsigned*)(F.lds + MISC_OFF);
    F.tid = threadIdx.x; F.lane = F.tid & 63; F.wave = __builtin_amdgcn_readfirstlane(F.tid >> 6);
    F.G = gridDim.x; { const int bx = blockIdx.x; F.vcu = (F.G % 8 == 0) ? (bx % 8) * (F.G / 8) + bx / 8 : bx; }
    F.ws = args.ws; F.out = args.out; F.ctl = (unsigned*)(args.ws + WS_CTL);
    for (int u = F.tid; u < (LDS_BYTES - LDSCTL_OFF) / 4; u += NWAVES * 64) ((LAS unsigned*)(F.lds + LDSCTL_OFF))[u] = 0u;
    __syncthreads();
    XcdBarrier bar; bar.bar = F.ctl + CW_BAR + args.li * XCD_BAR_WORDS; bar.x = 0; bar.st = nullptr;
    if (N_LAUNCHES != PER_PHASE) bar = xcd_barrier_post(F.ctl + CW_BAR + args.li * XCD_BAR_WORDS, F.MISC + 8);
#define GRID_BAR() do { if (N_LAUNCHES != PER_PHASE) xcd_barrier(bar); } while (0)
    const int lo = args.ph_lo, hi = args.ph_hi;
#define IN(k) (lo <= (k) && (k) < hi)
#define BOTH(k) (IN(k) && IN((k) + 1))
    bf16_t* XB = (bf16_t*)(F.ws + WS_XB); bf16_t* Hb = (bf16_t*)(F.ws + WS_H); bf16_t* MIXb = (bf16_t*)(F.ws + WS_MIX);
    bf16_t *Qb = (bf16_t*)(F.ws + WS_Q), *Kb = (bf16_t*)(F.ws + WS_K), *Vb = (bf16_t*)(F.ws + WS_V), *Ub = (bf16_t*)(F.ws + WS_U), *GVb = (bf16_t*)(F.ws + WS_GV);
    float* SSQ = (float*)(F.ws + WS_SSQ);
    const LAS float* rstab = (const LAS float*)(F.lds + RSTAB_OFF);

    if (IN(0)) { p0_prologue(F, args); if (BOTH(0)) GRID_BAR(); }
    if (IN(1)) {
        pg8::Gemm g{XB, (const bf16_t*)(F.ws + WS_WGU1), MT, NGU, DM}; pg8::StaticOrder S; S.init(MT, NGU, F.G, (int)blockIdx.x);
        rstab_fill(F, S);
        pg8::EpiSwiGLU E{Hb, rstab};
        pg8::gemm_phase<pg8::EpiSwiGLU, pg8::StaticOrder, true, true>(F.lds, g, S, E);
        if (BOTH(1)) GRID_BAR();
    }
    if (IN(2)) {
        pg8::Gemm g{Hb, (const bf16_t*)(F.ws + WS_WD1), MP, DM, DFF}; pg8::StaticOrder S; S.init(MP, DM, F.G, (int)blockIdx.x);
        pg8::EpiResid<0> E{args.in[I_XP], nullptr, XB, SSQ, 0.5f};
        pg8::gemm_phase<pg8::EpiResid<0>, pg8::StaticOrder, true, true>(F.lds, g, S, E);
        mini_gemm_resid<0>(F, Hb, (const bf16_t*)(F.ws + WS_WD1), DFF, args.in[I_XS], MP, nullptr, XB, 0.5f);
        if (BOTH(2)) GRID_BAR();
    }
    if (IN(3)) {
        pg8::Gemm g{XB, (const bf16_t*)(F.ws + WS_WIN), MT, NIN, DM}; pg8::StaticOrder S; S.init(MT, NIN, F.G, (int)blockIdx.x);
        rstab_fill(F, S);
        pg8::EpiWin E{Qb, Kb, Vb, Ub, GVb, F.out, args.in[I_GNORM], rstab, (LAS float*)(F.lds + GX_OFF)};
        pg8::gemm_phase<pg8::EpiWin, pg8::StaticOrder, true, true>(F.lds, g, S, E);
        if (BOTH(3)) GRID_BAR();
    }
    if (IN(4)) {
        float lam;
        { const float a = wave_sum(args.in[I_LQ1][F.lane] * args.in[I_LK1][F.lane]), c = wave_sum(args.in[I_LQ2][F.lane] * args.in[I_LK2][F.lane]); lam = __expf(a) - __expf(c) + LAM_INIT; }
        { const float* BT = (const float*)(F.ws + WS_BTAB); LAS float* btl = (LAS float*)(F.lds + att::L_BTAB); for (int e = F.tid; e < 1024; e += 512) btl[e] = BT[e]; }
        const int qid = (F.vcu * 8) / F.G;
        unsigned* qh = F.ctl + CW_Q + 64 * qid;
        volatile LAS unsigned* QW = F.MISC + 16;
        if (F.tid == 0) QW[0] = __hip_atomic_fetch_add(qh, 1u, __ATOMIC_RELAXED, __HIP_MEMORY_SCOPE_AGENT);
        __syncthreads();
#define NEXT_TICKET(body) do { unsigned tn_ = 0u; if (F.tid == 0) tn_ = __hip_atomic_fetch_add(qh, 1u, __ATOMIC_RELAXED, __HIP_MEMORY_SCOPE_AGENT); body; if (F.tid == 0) QW[0] = tn_; __syncthreads(); t = __builtin_amdgcn_readfirstlane((int)QW[0]); } while (0)
        int t = __builtin_amdgcn_readfirstlane((int)QW[0]);
        while (t < 16) { const int u = qid * 16 + t;
            NEXT_TICKET(att::sample_unit(u >> 2, u & 3, args.in[I_CK], args.in[I_CV], args.page_table, Qb, Kb, Vb, Ub, F.out + O_GS, args.in[I_WS], args.in[I_BS], MIXb, args.in[I_SUBLN], lam, F.lds)); }
        while (t < 80) { NEXT_TICKET(att::attn_unit(qid >> 2, qid & 3, 79 - t, Qb, Kb, Vb, MIXb, args.in[I_SUBLN], lam, F.lds)); }
        while (t < 96) { const int c = qid * 16 + (t - 80);
            NEXT_TICKET(for (int g = 0; g < 4; ++g) att::spatial_unit(c, g, GVb, Ub, (const bf16_t*)(F.ws + WS_WTRIL), args.in[I_BS], MIXb, F.lds)); }
#undef NEXT_TICKET
        if (BOTH(4)) GRID_BAR();
    }
    if (IN(5)) {
        pg8::Gemm g{MIXb, (const bf16_t*)(F.ws + WS_WOUT), MP, DM, DM}; pg8::StaticOrder S; S.init(MP, DM, F.G, (int)blockIdx.x);
        pg8::EpiResid<1> E{nullptr, nullptr, XB, SSQ, 1.0f};
        pg8::gemm_phase<pg8::EpiResid<1>, pg8::StaticOrder, true, true>(F.lds, g, S, E);
        mini_gemm_resid<1>(F, MIXb, (const bf16_t*)(F.ws + WS_WOUT), DM, nullptr, 0, nullptr, XB, 1.0f);
        if (BOTH(5)) GRID_BAR();
    }
    if (IN(6)) {
        pg8::Gemm g{XB, (const bf16_t*)(F.ws + WS_WGU2), MT, NGU, DM}; pg8::StaticOrder S; S.init(MT, NGU, F.G, (int)blockIdx.x);
        rstab_fill(F, S);
        pg8::EpiSwiGLU E{Hb, rstab};
        pg8::gemm_phase<pg8::EpiSwiGLU, pg8::StaticOrder, true, true>(F.lds, g, S, E);
        if (BOTH(6)) GRID_BAR();
    }
    if (IN(7)) {
        pg8::Gemm g{Hb, (const bf16_t*)(F.ws + WS_WD2), MP, DM, DFF}; pg8::StaticOrder S; S.init(MP, DM, F.G, (int)blockIdx.x);
        pg8::EpiResid<2> E{nullptr, F.out, XB, SSQ, 0.5f};
        pg8::gemm_phase<pg8::EpiResid<2>, pg8::StaticOrder, true, true>(F.lds, g, S, E);
        mini_gemm_resid<2>(F, Hb, (const bf16_t*)(F.ws + WS_WD2), DFF, nullptr, 0, F.out, XB, 0.5f);
        if (BOTH(7)) GRID_BAR();
    }
    if (IN(8)) {
        const unsigned bad = (N_LAUNCHES != PER_PHASE) ? __hip_atomic_load(F.ctl + CW_BAR + XB_TMO, __ATOMIC_RELAXED, __HIP_MEMORY_SCOPE_AGENT) : 0u;
        const int gw = F.vcu * NWAVES + F.wave, NGW = F.G * NWAVES; const float* gf = args.in[I_NFIN];
        const int ln9 = (int)__builtin_amdgcn_mbcnt_hi(~0u, __builtin_amdgcn_mbcnt_lo(~0u, 0u));
        for (int m = gw; m < MT; m += NGW) {
            const f32x4* p = (const f32x4*)(SSQ + (size_t)m * 16); const f32x4 s4 = (p[0] + p[1]) + (p[2] + p[3]);
            float rs = __builtin_amdgcn_rsqf(((s4[0] + s4[1]) + (s4[2] + s4[3])) * (1.f / DM) + EPS);
            if (bad) rs = __builtin_nanf("");
            f32x4* xr = (f32x4*)(F.out + (size_t)m * DM) + ln9;
#pragma unroll
            for (int j = 0; j < 4; ++j) { const f32x4 gg = ((const f32x4*)gf)[ln9 + 64 * j]; xr[64 * j] = xr[64 * j] * rs * gg; }
        }
    }
#undef IN
#undef BOTH
#undef GRID_BAR
}

extern "C" void kernel_launch(void* const* d_in, const int* in_sizes, int n_in, void* d_out, int out_size, void* d_ws, size_t ws_size, hipStream_t stream) {
    static int grid = 0;
    if (grid == 0) {
        if (n_in != 24 || (size_t)out_size != O_END || ws_size < WS_END) { fprintf(stderr, "kernel_launch: unexpected sizes (n_in %d out %d ws %zu)\n", n_in, out_size, ws_size); grid = -1; return; }
        int dev = 0, cus = 0, per_cu = 0;
        if (hipGetDevice(&dev) != hipSuccess || hipDeviceGetAttribute(&cus, hipDeviceAttributeMultiprocessorCount, dev) != hipSuccess) { grid = -1; return; }
        if (hipFuncSetAttribute((const void*)mega_fwd, hipFuncAttributeMaxDynamicSharedMemorySize, LDS_BYTES) != hipSuccess) { fprintf(stderr, "kernel_launch: hipFuncSetAttribute failed\n"); grid = -1; return; }
        if (hipOccupancyMaxActiveBlocksPerMultiprocessor(&per_cu, (const void*)mega_fwd, NWAVES * 64, LDS_BYTES) != hipSuccess || per_cu < 1) { fprintf(stderr, "kernel_launch: occupancy query reports %d\n", per_cu); }
        (void)hipGetLastError();
        grid = cus;
        if (grid != 256) { fprintf(stderr, "kernel_launch: built for 256 CUs, found %d\n", cus); grid = -1; return; }
    }
    if (grid < 0) return;
    if (hipMemsetAsync((char*)d_ws + WS_CTL, 0, CTL_ZERO_BYTES, stream) != hipSuccess) return;
    Args a{};
    for (int i = 0; i < 24; ++i) a.in[i] = (const float*)d_in[i];
    a.page_table = (const int*)d_in[I_PT]; a.out = (float*)d_out; a.ws = (unsigned char*)d_ws;
    if (N_LAUNCHES == 1) { a.ph_lo = 0; a.ph_hi = PER_PHASE; a.li = 0; hipLaunchKernelGGL(mega_fwd, dim3(grid), dim3(NWAVES * 64), LDS_BYTES, stream, a); }
    else { for (int li = 0; li < PER_PHASE; ++li) { a.ph_lo = li; a.ph_hi = li + 1; a.li = 0; hipLaunchKernelGGL(mega_fwd, dim3(grid), dim3(NWAVES * 64), LDS_BYTES, stream, a); } }
    const hipError_t le = hipPeekAtLastError();
    if (le != hipSuccess) fprintf(stderr, "kernel_launch: launch failed: %s\n", hipGetErrorName(le));
}
```
